# Optimizing an MI355X kernel written in HIP

```python
import jax, jax.numpy as jnp
from jax import lax
import numpy as np

D_MODEL = 1024
BATCH = 8
SEQ = 2048
DEPTH = 2

CHUNK = 64
N_META = 16

SB_HEAD_DIM = 64
SB_WIDTH = D_MODEL // 2
N_SB_HEADS = SB_WIDTH // SB_HEAD_DIM
Q_BLOCK = 128

POOL_WINDOWS = (2, 4, 8, 16)
N_POOL_GROUPS = len(POOL_WINDOWS)
POOL_WIDTH = D_MODEL // 2
POOL_GROUP_DIM = POOL_WIDTH // N_POOL_GROUPS

N_BRANCHES = 2
N_IN = 3 * SB_WIDTH + POOL_WIDTH + N_BRANCHES * D_MODEL

D_FF = ((-(-8 * D_MODEL // 3) + 255) // 256) * 256
RMS_EPS = 1e-6

kernel_name = "hybrid_pool_stickbreak_meta"


def rms_norm(x, g):
    xf = x.astype(jnp.float32)
    y = xf * lax.rsqrt(jnp.mean(xf * xf, axis=-1, keepdims=True) + RMS_EPS)
    return (y * g.astype(jnp.float32)).astype(x.dtype)


def pool_mixer(u, mix, scale):
    b, l, _ = u.shape
    uf = u.astype(jnp.float32)
    cs0 = jnp.pad(jnp.cumsum(uf, axis=1), ((0, 0), (1, 0), (0, 0)))
    pos = jnp.arange(l)
    means = []
    for g, w in enumerate(POOL_WINDOWS):
        c = cs0[:, :, g * POOL_GROUP_DIM:(g + 1) * POOL_GROUP_DIM]
        cur = c[:, 1:]
        lag = jnp.pad(c, ((0, 0), (w - 1, 0), (0, 0)))[:, :l]
        cnt = jnp.minimum(pos + 1, w).astype(jnp.float32)[None, :, None]
        means.append((cur - lag) / cnt)
    pooled = jnp.stack(means, axis=2)
    diff = (pooled - uf.reshape(b, l, N_POOL_GROUPS, POOL_GROUP_DIM)).astype(u.dtype)
    mixed = jnp.einsum('blgc,gcd->blgd', diff, mix)
    return mixed.reshape(b, l, POOL_WIDTH) * scale


def stick_breaking_attention(q, k, v):
    b, l, h, dh = q.shape
    lp = -(-l // Q_BLOCK) * Q_BLOCK
    padw = ((0, 0), (0, lp - l), (0, 0), (0, 0))
    qh, kh, vh = [jnp.pad(a, padw).transpose(0, 2, 1, 3) for a in (q, k, v)]
    scale = 1.0 / float(np.sqrt(dh))
    outs = []
    for i in range(lp // Q_BLOCK):
        q0 = i * Q_BLOCK
        kend = q0 + Q_BLOCK
        qb = qh[:, :, q0:kend]
        kb = kh[:, :, :kend]
        vb = vh[:, :, :kend]
        z = jnp.einsum('bhqd,bhkd->bhqk', qb, kb).astype(jnp.float32) * scale
        t_idx = q0 + jnp.arange(Q_BLOCK)
        s_idx = jnp.arange(kend)
        mask = s_idx[None, :] < t_idx[:, None]
        log_keep = jnp.where(mask, jax.nn.log_sigmoid(-z), 0.0)
        log_stick = lax.cumsum(log_keep, axis=3, reverse=True) - log_keep
        w = jnp.where(mask, jnp.exp(jax.nn.log_sigmoid(z) + log_stick), 0.0)
        outs.append(jnp.einsum('bhqk,bhkd->bhqd', w.astype(v.dtype), vb))
    o = jnp.concatenate(outs, axis=2)[:, :, :l]
    return o.transpose(0, 2, 1, 3).reshape(b, l, h * dh)


def hybrid_layer(x, norm1_g, w_in, b_gate, pool_mix, pool_scale, w_branch_pool, w_branch_sb,
                 w_out, norm2_g, w_ffn_in, w_ffn_out):
    b, l, _ = x.shape
    h = rms_norm(x, norm1_g)
    proj = h @ w_in
    q, k, v, u, gate_pre = jnp.split(
        proj, [SB_WIDTH, 2 * SB_WIDTH, 3 * SB_WIDTH, 3 * SB_WIDTH + POOL_WIDTH], axis=-1)
    gates = jax.nn.sigmoid(gate_pre + b_gate)
    g_pool, g_sb = jnp.split(gates, N_BRANCHES, axis=-1)
    a = pool_mixer(u, pool_mix, pool_scale)
    hs = (b, l, N_SB_HEADS, SB_HEAD_DIM)
    s = stick_breaking_attention(q.reshape(hs), k.reshape(hs), v.reshape(hs))
    merged = g_pool * (a @ w_branch_pool) + g_sb * (s @ w_branch_sb)
    x = x + merged @ w_out
    h2 = rms_norm(x, norm2_g)
    gt, up = jnp.split(h2 @ w_ffn_in, 2, axis=-1)
    return x + (jax.nn.silu(gt) * up) @ w_ffn_out


def setup_inputs(seed: int = 0) -> dict:
    key = jax.random.key(seed)
    ks = jax.random.split(key, 16)
    f = jnp.float32
    nrm = lambda kk, shape, s: jax.random.normal(kk, shape, f) * s
    return {
        "x": nrm(ks[0], (BATCH, SEQ, D_MODEL), 1.0),
        "meta_tokens": nrm(ks[1], (N_META, D_MODEL), 1.0),
        "norm1_g": 1.0 + nrm(ks[2], (DEPTH, D_MODEL), 0.02),
        "w_in": nrm(ks[3], (DEPTH, D_MODEL, N_IN), D_MODEL ** -0.5),
        "b_gate": nrm(ks[4], (DEPTH, N_BRANCHES * D_MODEL), 0.02),
        "pool_mix": nrm(ks[5], (DEPTH, N_POOL_GROUPS, POOL_GROUP_DIM, POOL_GROUP_DIM), POOL_GROUP_DIM ** -0.5),
        "pool_scale": 1.0 + nrm(ks[6], (DEPTH, POOL_WIDTH), 0.02),
        "w_branch_pool": nrm(ks[7], (DEPTH, POOL_WIDTH, D_MODEL), POOL_WIDTH ** -0.5),
        "w_branch_sb": nrm(ks[8], (DEPTH, SB_WIDTH, D_MODEL), SB_WIDTH ** -0.5),
        "w_out": nrm(ks[9], (DEPTH, D_MODEL, D_MODEL), D_MODEL ** -0.5),
        "norm2_g": 1.0 + nrm(ks[10], (DEPTH, D_MODEL), 0.02),
        "w_ffn_in": nrm(ks[11], (DEPTH, D_MODEL, 2 * D_FF), D_MODEL ** -0.5),
        "w_ffn_out": nrm(ks[12], (DEPTH, D_FF, D_MODEL), D_FF ** -0.5),
        "final_norm_g": 1.0 + nrm(ks[13], (D_MODEL,), 0.02),
    }


def reference(x, meta_tokens, norm1_g, w_in, b_gate, pool_mix, pool_scale, w_branch_pool,
              w_branch_sb, w_out, norm2_g, w_ffn_in, w_ffn_out, final_norm_g):
    b = x.shape[0]
    meta = jnp.broadcast_to(meta_tokens[None].astype(x.dtype), (b, N_META, x.shape[-1]))
    hcat = jnp.concatenate([meta, x], axis=1)
    for layer in range(DEPTH):
        hcat = hybrid_layer(hcat, norm1_g[layer], w_in[layer], b_gate[layer], pool_mix[layer],
                            pool_scale[layer], w_branch_pool[layer], w_branch_sb[layer],
                            w_out[layer], norm2_g[layer], w_ffn_in[layer], w_ffn_out[layer])
    hcat = rms_norm(hcat, final_norm_g)
    return hcat[:, N_META:]
```

```cpp
#define MK_LAUNCH_PER_PHASE 0
#include <hip/hip_runtime.h>
#include <cstdio>
#include <cstdint>
namespace pg8 {
#define PG8_LAS __attribute__((address_space(3)))
typedef unsigned short bf16_t;
typedef short bf16x8 __attribute__((ext_vector_type(8)));
typedef float f32x4 __attribute__((ext_vector_type(4)));
typedef unsigned u32x4 __attribute__((ext_vector_type(4)));
constexpr int BM = 256, BK = 64, HALF = 128, HTB = HALF * BK * 2  , STAGE_BYTES = 8 * HTB, NXCD = 8, WGM = 8;

__host__ __device__ __forceinline__ int lds_byte(int r, int c) { const int st = (r >> 4) * 2 + (c >> 5), rr = r & 15, cc = c & 31, ob = rr * 64 + cc * 2; return st * 1024 + (ob ^ (((ob >> 9) & 1) << 5)); }
__host__ __device__ __forceinline__ void stage_rc(int b, int& R, int& C) { const int st = b / 1024, sb = b % 1024, swz = sb ^ (((sb >> 9) & 1) << 5); R = (st >> 1) * 16 + swz / 64; C = (st & 1) * 32 + (swz % 64) / 2; }
__host__ __device__ __forceinline__ int perm32(int rho) { const int n = rho >> 4, i = rho & 15; return 8 * (i >> 2) + 4 * n + (i & 3); }

struct Unit { int pm, pn; };
struct Gemm { const bf16_t* A; const bf16_t* Bt; int M, N, K; };

struct StaticOrder {
    int nM, nN, nwg, G, c;
    __host__ __device__ void init(int M, int N, int G_, int c_) { nM = M / BM; nN = N / BM; nwg = nM * nN; G = G_; c = c_; }
    __host__ __device__ bool next(int i, Unit& u) const {
        const long L = (long)i * G + c; if (L >= nwg) return false;
        int wgid = (int)L; { const int q = nwg / NXCD, r = nwg % NXCD, xcd = wgid % NXCD, off = wgid / NXCD; wgid = (xcd < r ? xcd * (q + 1) : r * (q + 1) + (xcd - r) * q) + off; }
        const int nig = WGM * nN, gid = wgid / nig, fm = gid * WGM, gsz = (nM - fm) < WGM ? (nM - fm) : WGM;
        u.pm = fm + ((wgid % nig) % gsz); u.pn = (wgid % nig) / gsz; return true;
    }
    __device__ __forceinline__ void a_ready(const Unit&) const {}
    __device__ __forceinline__ void done(const Unit&) const {}
};

__device__ __forceinline__ unsigned cvt_pk_bf16(float lo, float hi) { unsigned r; asm volatile("v_cvt_pk_bf16_f32 %0, %1, %2" : "=v"(r) : "v"(lo), "v"(hi)); return r; }
template <class Epi, class Sched, bool ALIGN_EPI = false, bool SP2 = false>
__device__ __forceinline__ void gemm_phase(PG8_LAS unsigned char* lds, const Gemm g, const Sched& S, const Epi& E) {
    int tid = threadIdx.x; asm volatile("" : "+v"(tid));
    const int wid = __builtin_amdgcn_readfirstlane(tid >> 6), lane = tid & 63, wr = wid >> 2, wc = wid & 3, fr = lane & 15, fq = lane >> 4;
    const int K = g.K, nt = K / BK;
    unsigned voffA[2], voffB[2];
#pragma unroll
    for (int i = 0; i < 2; ++i) { int R, C; stage_rc(tid * 16 + i * 8192, R, C); const int Rb = Epi::PERM ? ((R & ~31) + perm32(R & 31)) : R;
        voffA[i] = (unsigned)(R * K + C) * 2u; voffB[i] = (unsigned)(Rb * K + C) * 2u; }
    const size_t kstep = (size_t)(BK * 2);
    const size_t hstep = (size_t)HALF * K * 2;
    const size_t tstep = 2 * hstep;
    const unsigned ldsw = (unsigned)wid * 1024u;
    const int aoff = lds_byte(wr * 64 + fr, fq * 8), boff = lds_byte(wc * 32 + fr, fq * 8);
#define PG8_SA(b, h) (((b) * 2 + (h)) * HTB)
#define PG8_SB(b, h) ((4 + (b) * 2 + (h)) * HTB)
#define PG8_STAGE(bufoff, gbase, voff) do { _Pragma("unroll") for (int _i = 0; _i < 2; ++_i) \
        __builtin_amdgcn_global_load_lds((const unsigned*)((const char*)(gbase) + (voff)[_i]), (PG8_LAS unsigned*)(lds + (bufoff) + ldsw + _i * 8192), 16, 0, 0); } while (0)
#define PG8_LDA(dst, b, h) do { _Pragma("unroll") for (int m = 0; m < 4; ++m) _Pragma("unroll") for (int k = 0; k < 2; ++k) dst[m][k] = *(const PG8_LAS bf16x8*)(lds + PG8_SA(b, h) + aoff + m * 2048 + k * 1024); } while (0)
#define PG8_LDB(dst, b, h) do { _Pragma("unroll") for (int n = 0; n < 2; ++n) _Pragma("unroll") for (int k = 0; k < 2; ++k) dst[n][k] = *(const PG8_LAS bf16x8*)(lds + PG8_SB(b, h) + boff + n * 2048 + k * 1024); } while (0)
#define PG8_MMA(ai, bj, At, Bt) do { __builtin_amdgcn_s_setprio(1); _Pragma("unroll") for (int m = 0; m < 4; ++m) _Pragma("unroll") for (int n = 0; n < 2; ++n) _Pragma("unroll") for (int k = 0; k < 2; ++k) \
        acc[ai][bj][m][n] = __builtin_amdgcn_mfma_f32_16x16x32_bf16(Bt[n][k], At[m][k], acc[ai][bj][m][n], 0, 0, 0); __builtin_amdgcn_s_setprio(0); } while (0)
#define PG8_WAIT_V(n) asm volatile("s_waitcnt vmcnt(" #n ")" ::: "memory")
#define PG8_WAIT_L(n) asm volatile("s_waitcnt lgkmcnt(" #n ")" ::: "memory")
#define PG8_BAR __builtin_amdgcn_s_barrier()
#define PG8_SCHED __builtin_amdgcn_sched_barrier(0)
    Unit cur, nxt; int ui = 0;
    if (!S.next(0, cur)) return;
    f32x4 acc[2][2][4][2];
#pragma unroll
    for (int a = 0; a < 2; ++a)
#pragma unroll
        for (int b = 0; b < 2; ++b)
#pragma unroll
            for (int m = 0; m < 4; ++m)
#pragma unroll
                for (int n = 0; n < 2; ++n) acc[a][b][m][n] = (f32x4){0.f, 0.f, 0.f, 0.f};
    bf16x8 At[4][2], B0[2][2], B1[2][2];
    const char* cA = (const char*)g.A + (size_t)cur.pm * tstep; const char* cB = (const char*)g.Bt + (size_t)cur.pn * tstep;
    S.a_ready(cur);
    if constexpr (SP2) {
        PG8_STAGE(PG8_SB(0, 0), cB, voffB); PG8_STAGE(PG8_SB(0, 1), cB + hstep, voffB); PG8_STAGE(PG8_SA(0, 0), cA, voffA); PG8_STAGE(PG8_SA(0, 1), cA + hstep, voffA);
        if (wr == 1) PG8_BAR;
        PG8_WAIT_V(2); PG8_BAR;
        PG8_STAGE(PG8_SB(1, 0), cB + kstep, voffB); PG8_STAGE(PG8_SA(1, 0), cA + kstep, voffA); PG8_STAGE(PG8_SB(1, 1), cB + hstep + kstep, voffB);
        PG8_WAIT_V(6); PG8_BAR;
    } else {
        PG8_STAGE(PG8_SB(0, 0), cB, voffB); PG8_STAGE(PG8_SA(0, 0), cA, voffA); PG8_STAGE(PG8_SB(0, 1), cB + hstep, voffB); PG8_STAGE(PG8_SA(0, 1), cA + hstep, voffA);
        if (wr == 1) PG8_BAR;
        PG8_WAIT_V(4); PG8_BAR;
        PG8_STAGE(PG8_SB(1, 0), cB + kstep, voffB); PG8_STAGE(PG8_SA(1, 0), cA + kstep, voffA); PG8_STAGE(PG8_SB(1, 1), cB + hstep + kstep, voffB);
        PG8_WAIT_V(6); PG8_BAR;
    }
    for (;;) {
        const bool has_next = S.next(ui + 1, nxt);
        const char* nA = has_next ? (const char*)g.A + (size_t)nxt.pm * tstep : cA; const char* nB = has_next ? (const char*)g.Bt + (size_t)nxt.pn * tstep : cB;
        for (int t = 0; t < nt; t += 2) {
            const bool last = (t == nt - 2);
            const char* a1 = cA + (size_t)(t + 1) * kstep;
            const char* a2 = last ? nA : cA + (size_t)(t + 2) * kstep; const char* b2 = last ? nB : cB + (size_t)(t + 2) * kstep;
            const char* a3 = a2 + kstep; const char* b3 = b2 + kstep;
            if (last && has_next) S.a_ready(nxt);
            if constexpr (SP2) {
            PG8_LDB(B0, 0, 0); PG8_LDB(B1, 0, 1); PG8_SCHED; PG8_LDA(At, 0, 0); PG8_STAGE(PG8_SA(1, 1), a1 + hstep, voffA);
            PG8_WAIT_V(8); PG8_WAIT_L(0); PG8_BAR; PG8_MMA(0, 0, At, B0); PG8_MMA(0, 1, At, B1); PG8_BAR; PG8_SCHED;
            PG8_LDA(At, 0, 1); PG8_STAGE(PG8_SB(0, 0), b2, voffB); PG8_STAGE(PG8_SB(0, 1), b2 + hstep, voffB); PG8_STAGE(PG8_SA(0, 0), a2, voffA);
            PG8_WAIT_V(8); PG8_WAIT_L(0); PG8_BAR; PG8_MMA(1, 0, At, B0); PG8_MMA(1, 1, At, B1); PG8_BAR; PG8_SCHED;
            PG8_LDB(B0, 1, 0); PG8_LDB(B1, 1, 1); PG8_SCHED; PG8_LDA(At, 1, 0); PG8_STAGE(PG8_SA(0, 1), a2 + hstep, voffA);
            PG8_WAIT_V(8); PG8_WAIT_L(0); PG8_BAR; PG8_MMA(0, 0, At, B0); PG8_MMA(0, 1, At, B1); PG8_BAR; PG8_SCHED;
            PG8_LDA(At, 1, 1); PG8_STAGE(PG8_SB(1, 0), b3, voffB); PG8_STAGE(PG8_SB(1, 1), b3 + hstep, voffB); PG8_STAGE(PG8_SA(1, 0), a3, voffA);
            PG8_WAIT_V(8); PG8_WAIT_L(0); PG8_BAR; PG8_MMA(1, 0, At, B0); PG8_MMA(1, 1, At, B1); PG8_BAR; PG8_SCHED;
            } else {
            PG8_LDB(B0, 0, 0); PG8_SCHED; PG8_LDA(At, 0, 0); PG8_STAGE(PG8_SA(1, 1), a1 + hstep, voffA);
            PG8_WAIT_L(8); PG8_BAR; PG8_WAIT_L(0); PG8_MMA(0, 0, At, B0); PG8_BAR; PG8_SCHED;
            PG8_LDB(B1, 0, 1); PG8_STAGE(PG8_SB(0, 0), b2, voffB);
            PG8_BAR; PG8_WAIT_L(0); PG8_MMA(0, 1, At, B1); PG8_BAR;
            PG8_LDA(At, 0, 1); PG8_STAGE(PG8_SA(0, 0), a2, voffA);
            PG8_BAR; PG8_WAIT_L(0); PG8_MMA(1, 0, At, B0); PG8_BAR; PG8_SCHED;
            PG8_STAGE(PG8_SB(0, 1), b2 + hstep, voffB);
            PG8_WAIT_V(6); PG8_BAR; PG8_MMA(1, 1, At, B1); PG8_BAR;
            PG8_LDB(B0, 1, 0); PG8_SCHED; PG8_LDA(At, 1, 0); PG8_STAGE(PG8_SA(0, 1), a2 + hstep, voffA);
            PG8_WAIT_L(8); PG8_BAR; PG8_WAIT_L(0); PG8_MMA(0, 0, At, B0); PG8_BAR; PG8_SCHED;
            PG8_LDB(B1, 1, 1); PG8_STAGE(PG8_SB(1, 0), b3, voffB);
            PG8_BAR; PG8_WAIT_L(0); PG8_MMA(0, 1, At, B1); PG8_BAR;
            PG8_LDA(At, 1, 1); PG8_STAGE(PG8_SA(1, 0), a3, voffA);
            PG8_BAR; PG8_WAIT_L(0); PG8_MMA(1, 0, At, B0); PG8_BAR; PG8_SCHED;
            PG8_STAGE(PG8_SB(1, 1), b3 + hstep, voffB);
            PG8_WAIT_V(6); PG8_BAR; PG8_MMA(1, 1, At, B1); PG8_BAR;
            }
        }
        if constexpr (ALIGN_EPI) { if (wr == 0) PG8_BAR; }
        if constexpr (!Epi::AFTER_DRAIN) { E(acc, cur, wr, wc, fr, fq); S.done(cur); }
        if (!has_next) break;
#pragma unroll
        for (int a = 0; a < 2; ++a)
#pragma unroll
            for (int b = 0; b < 2; ++b)
#pragma unroll
                for (int m = 0; m < 4; ++m)
#pragma unroll
                    for (int n = 0; n < 2; ++n) acc[a][b][m][n] = (f32x4){0.f, 0.f, 0.f, 0.f};
        cur = nxt; cA = nA; cB = nB; ++ui;
        if constexpr (ALIGN_EPI) { if (wr == 1) PG8_BAR; }
    }
    PG8_WAIT_V(0);
    if constexpr (!ALIGN_EPI) { if (wr == 0) PG8_BAR; }
    PG8_BAR;
    if constexpr (Epi::AFTER_DRAIN) { E.fused(acc, cur, wr, wc, fr, fq, lds, wid, lane); S.done(cur); }
#undef PG8_SA
#undef PG8_SB
#undef PG8_STAGE
#undef PG8_LDA
#undef PG8_LDB
#undef PG8_MMA
#undef PG8_WAIT_V
#undef PG8_WAIT_L
#undef PG8_BAR
#undef PG8_SCHED
}
}

#ifndef PG8_SP2
#define PG8_SP2 true
#endif
#ifndef PG8_ALIGN
#define PG8_ALIGN true
#endif

constexpr int NWAVES = 8;
constexpr int D = 1024, NB = 8, SEQ = 2048, NMETA = 16, LTOT = SEQ + NMETA, DEPTH = 2;
constexpr int M_MAIN = NB * SEQ;
constexpr int M_PAD = M_MAIN + 256;
constexpr int NIN = 4096, NH = 8, HD = 64, DFF = 2816, NF1 = 2 * DFF;
constexpr float RMS_EPS = 1e-6f;
constexpr float LOG2E = 1.4426950408889634f;
constexpr float QSCALE = 0.125f * LOG2E;
#ifndef EARLY_EXIT
#define EARLY_EXIT 1
#endif

constexpr size_t MiB = 1u << 20;
constexpr size_t WS_CTL = 0, CTL_ZERO_BYTES = 1 * MiB;
constexpr size_t WS_WIN = 1 * MiB;
constexpr size_t WS_WBP = 17 * MiB;
constexpr size_t WS_WBS = 19 * MiB;
constexpr size_t WS_WOUT = 21 * MiB;
constexpr size_t WS_WF1 = 25 * MiB;
constexpr size_t WS_WF2 = 47 * MiB;
constexpr size_t WS_SSA = 58 * MiB;
constexpr size_t WS_SSB = WS_SSA + 1280 * 1024;
constexpr size_t WS_XM = WS_SSB + 1280 * 1024;
constexpr size_t WS_XB = 62 * MiB;
constexpr size_t ACT16 = (size_t)M_PAD * 512 * 2;
constexpr size_t WS_A = WS_XB, WS_S = WS_XB + ACT16;
constexpr size_t WS_Q = WS_XB + 2 * ACT16;
constexpr size_t WS_U = WS_Q + ACT16, WS_K = WS_U + ACT16, WS_V = WS_K + ACT16, WS_G = WS_V + ACT16;
static_assert(WS_K == WS_U + ACT16 && WS_V == WS_U + 2 * ACT16, "EpiIn addresses K and V relative to U");
constexpr size_t WS_MP = WS_Q, WS_MG = WS_K, WS_HM = WS_Q;
constexpr size_t WS_END = WS_G + 4 * ACT16;
constexpr size_t WS_WUT = WS_END;
static_assert(WS_XM + 1 * MiB <= WS_XB && WS_WF2 + 11 * MiB <= WS_SSA && WS_WUT + 4 * MiB <= 256 * MiB, "d_ws map");
static_assert(WS_HM + (size_t)M_PAD * DFF * 2 <= WS_END, "HM overlay");
constexpr int CW_TMO = 0, CW_CODE = 1;
constexpr int CW_BAR = 4096;

constexpr int RING_OFF = 0, RING_BYTES = 131072;
constexpr int LDSCTL_OFF = RING_BYTES, MISC_OFF = LDSCTL_OFF + 320;
constexpr int LDS_BYTES = 147456;
static_assert(MISC_OFF + 128 <= LDS_BYTES, "LDS map");
#define GAS __attribute__((address_space(1)))
#define LAS __attribute__((address_space(3)))
typedef unsigned short bf16;
typedef unsigned v4u __attribute__((ext_vector_type(4)));
typedef float f32x4 __attribute__((ext_vector_type(4)));
typedef short bf16x8 __attribute__((ext_vector_type(8)));
typedef GAS unsigned gu32;
typedef GAS unsigned long long gu64;
#define RLX_AGENT __ATOMIC_RELAXED, __HIP_MEMORY_SCOPE_AGENT
#define LDS_WAIT() asm volatile("s_waitcnt lgkmcnt(0)" ::: "memory")
#define VM_WAIT() asm volatile("s_waitcnt vmcnt(0)" ::: "memory")
__device__ __forceinline__ unsigned long long rt() { return __builtin_amdgcn_s_memrealtime(); }
__device__ __forceinline__ unsigned f2bf(float f) { unsigned u = __builtin_bit_cast(unsigned, f); return (u + 0x7fffu + ((u >> 16) & 1u)) >> 16; }
__device__ __forceinline__ unsigned pk2(float lo, float hi) { return f2bf(lo) | (f2bf(hi) << 16); }

#define XB_TMO      128
#define XB_XCNT(j)  (256  + 64 * (j))
#define XB_XSUB(j)  (1280 + 64 * (j))
#define XB_XGEN(j)  (2304 + 64 * (j))
#define XB_TOP      3328
#define XB_TOPGEN   3392
#define XCD_BAR_WORDS 3456
#define XB_SPIN_CAP (1u << 18)

__device__ __forceinline__ unsigned xb_ld(unsigned* p)              { return __hip_atomic_load(p, __ATOMIC_RELAXED, __HIP_MEMORY_SCOPE_AGENT); }
__device__ __forceinline__ unsigned xb_add(unsigned* p, unsigned v) { return __hip_atomic_fetch_add(p, v, __ATOMIC_RELAXED, __HIP_MEMORY_SCOPE_AGENT); }
__device__ __forceinline__ unsigned xb_xcc_id() { return (unsigned)__builtin_amdgcn_s_getreg((3 << 11) | 20) & 0xFu; }
#define XB_SPIN(cond, bar) do { unsigned _sp = 0; while (cond) { __builtin_amdgcn_s_sleep(1); \
    if ((++_sp & 255u) == 0u) { if (xb_ld(&(bar)[XB_TMO])) break; if (_sp > XB_SPIN_CAP) { atomicAdd(&(bar)[XB_TMO], 1u); break; } } } } while (0)

struct XcdBarrier {
    unsigned* bar; unsigned x;
    volatile LAS unsigned* st;
};

__device__ __forceinline__ XcdBarrier xcd_barrier_post(unsigned* bar, volatile LAS unsigned* st) {
    XcdBarrier b; b.bar = bar; b.x = xb_xcc_id(); b.st = st;
    if (threadIdx.x == 0) (void)xb_add(&bar[XB_XCNT(b.x)], 1u);
    return b;
}
__device__ __forceinline__ void xcd_barrier_complete(unsigned* bar, unsigned x, unsigned& nloc, unsigned& nx) {
    const unsigned G = gridDim.x * gridDim.y * gridDim.z;
    unsigned sum, cnt, mine, sp = 0u;
    for (;;) {
        sum = 0u; cnt = 0u; mine = 0u;
#pragma unroll
        for (unsigned j = 0; j < 16; ++j) { const unsigned c = xb_ld(&bar[XB_XCNT(j)]); sum += c; cnt += (c > 0u) ? 1u : 0u; mine = (j == x) ? c : mine; }
        if (sum == G) break;
        __builtin_amdgcn_s_sleep(1);
        if ((++sp & 255u) == 0u) { if (xb_ld(&bar[XB_TMO])) break; if (sp > XB_SPIN_CAP) { atomicAdd(&bar[XB_TMO], 1u); break; } }
    }
    nloc = mine > 0u ? mine : 1u; nx = cnt > 0u ? cnt : 1u;
}

__device__ __forceinline__ void xcd_barrier(const XcdBarrier& b) {
    asm volatile("s_waitcnt vmcnt(0)" ::: "memory");
    __syncthreads();
    if (threadIdx.x == 0) {
        unsigned* bar = b.bar;
        __builtin_amdgcn_s_waitcnt(0);
        unsigned nloc = b.st[0], nx = b.st[1];
        if (nloc == 0u) { xcd_barrier_complete(bar, b.x, nloc, nx); b.st[0] = nloc; b.st[1] = nx; }
        const unsigned old = xb_add(&bar[XB_XSUB(b.x)], 1u);
        const unsigned gen = old / nloc;
        if (old + 1u == (gen + 1u) * nloc) {
            __builtin_amdgcn_fence(__ATOMIC_RELEASE, "agent");
            asm volatile("s_waitcnt vmcnt(0)" ::: "memory");
            const unsigned og = xb_add(&bar[XB_TOP], 1u);
            const unsigned tg = og / nx;
            if (og + 1u == (tg + 1u) * nx) xb_add(&bar[XB_TOPGEN], 1u);
            else XB_SPIN(xb_ld(&bar[XB_TOPGEN]) == tg, bar);
            __builtin_amdgcn_fence(__ATOMIC_ACQUIRE, "agent");
            xb_add(&bar[XB_XGEN(b.x)], 1u);
            asm volatile("s_waitcnt vmcnt(0)" ::: "memory");
        } else {
            XB_SPIN(xb_ld(&bar[XB_XGEN(b.x)]) == gen, bar);
            __builtin_amdgcn_fence(__ATOMIC_ACQUIRE, "agent");
            asm volatile("s_waitcnt vmcnt(0)" ::: "memory");
        }
    }
    __syncthreads();
}


namespace epi {
using pg8::f32x4; using pg8::u32x4; using pg8::Unit;
typedef float f32x2_t __attribute__((ext_vector_type(2))); typedef __bf16 bf16x2_t __attribute__((ext_vector_type(2)));
__device__ __forceinline__ unsigned cvt_pk_bf16(float lo, float hi) { f32x2_t v = {lo, hi}; bf16x2_t b = __builtin_convertvector(v, bf16x2_t); return __builtin_bit_cast(unsigned, b); }
typedef GAS unsigned short bf16_t;
typedef GAS float gfloat; typedef GAS f32x4 gf32x4; typedef GAS u32x4 gu32x4;
__device__ __forceinline__ float row_rs(const gfloat* ss, int row) {
    const gf32x4* sp = (const gf32x4*)(ss + (size_t)row * 4);
    const f32x4 a = sp[0], b = sp[M_PAD], c = sp[2 * M_PAD], d = sp[3 * M_PAD];
    const f32x4 t = (a + b) + (c + d);
    const float s = (t[0] + t[1]) + (t[2] + t[3]);
    return __builtin_amdgcn_rsqf(s * (1.0f / 1024.0f) + RMS_EPS);
}
__device__ __forceinline__ float sigmoidf_(float x) { return __builtin_amdgcn_rcpf(1.0f + __builtin_amdgcn_exp2f(-LOG2E * x)); }
__device__ __forceinline__ u32x4 pack8(const f32x4 v0, const f32x4 v1) { u32x4 w; w.x = cvt_pk_bf16(v0[0], v0[1]); w.y = cvt_pk_bf16(v0[2], v0[3]); w.z = cvt_pk_bf16(v1[0], v1[1]); w.w = cvt_pk_bf16(v1[2], v1[3]); return w; }
__device__ __forceinline__ void unpack8(const u32x4 w, f32x4& v0, f32x4& v1) {
    v0[0] = __uint_as_float(w.x << 16); v0[1] = __uint_as_float(w.x & 0xffff0000u); v0[2] = __uint_as_float(w.y << 16); v0[3] = __uint_as_float(w.y & 0xffff0000u);
    v1[0] = __uint_as_float(w.z << 16); v1[1] = __uint_as_float(w.z & 0xffff0000u); v1[2] = __uint_as_float(w.w << 16); v1[3] = __uint_as_float(w.w & 0xffff0000u);
}

struct EpiIn {
    static constexpr bool PERM = true, AFTER_DRAIN = false;
    bf16_t *Q, *UKV, *G; const gfloat* ss; const gfloat* bias;
    __device__ __forceinline__ void operator()(const f32x4 (&acc)[2][2][4][2], const Unit& u, int wr, int wc, int fr, int fq) const {
        int cb = wc * 32 + 8 * fq; asm volatile("" : "+v"(cb), "+v"(fr)); const int pn = u.pn, pm = u.pm;
        if (pn < 2) {
#pragma unroll
            for (int ai = 0; ai < 2; ++ai)
#pragma unroll
                for (int m = 0; m < 4; ++m) { const int row = pm * 256 + ai * 128 + wr * 64 + m * 16 + fr; const float rs = row_rs(ss, row) * QSCALE;
                    bf16_t* rp = Q + (size_t)row * 512 + pn * 256 + cb;
#pragma unroll
                    for (int bj = 0; bj < 2; ++bj) *(gu32x4*)(rp + bj * 128) = pack8(acc[ai][bj][m][0] * rs, acc[ai][bj][m][1] * rs); }
        } else if (pn < 8) {
            bf16_t* base = UKV + (size_t)((pn >> 1) % 3) * (ACT16 / 2); const int c0 = (pn & 1) * 256 + cb;
            if (pm < 64) {
#pragma unroll
                for (int ai = 0; ai < 2; ++ai)
#pragma unroll
                    for (int m = 0; m < 4; ++m) { const int row = pm * 256 + ai * 128 + wr * 64 + m * 16 + fr; const float rs = row_rs(ss, row);
                        const int drow = row + 16 * ((row >> 11) + 1);
                        bf16_t* rp = base + (size_t)drow * 512 + c0;
#pragma unroll
                        for (int bj = 0; bj < 2; ++bj) *(gu32x4*)(rp + bj * 128) = pack8(acc[ai][bj][m][0] * rs, acc[ai][bj][m][1] * rs); }
            } else if (wr == 0) {
                const float rs = row_rs(ss, M_MAIN + fr);
#pragma unroll
                for (int bj = 0; bj < 2; ++bj) { const u32x4 w = pack8(acc[0][bj][0][0] * rs, acc[0][bj][0][1] * rs);
#pragma unroll
                    for (int b2 = 0; b2 < NB; ++b2) *(gu32x4*)(base + (size_t)(b2 * LTOT + fr) * 512 + c0 + bj * 128) = w; }
            }
        } else {
            const int gc = (pn - 8) * 256 + cb;
            f32x4 bv[2][2];
#pragma unroll
            for (int bj = 0; bj < 2; ++bj)
#pragma unroll
                for (int n = 0; n < 2; ++n) bv[bj][n] = *(const gf32x4*)(bias + gc + bj * 128 + 4 * n);
#pragma unroll
            for (int ai = 0; ai < 2; ++ai)
#pragma unroll
                for (int m = 0; m < 4; ++m) { const int row = pm * 256 + ai * 128 + wr * 64 + m * 16 + fr; const float rs = row_rs(ss, row);
                    bf16_t* rp = G + (size_t)row * 2048 + gc;
#pragma unroll
                    for (int bj = 0; bj < 2; ++bj) { f32x4 v0 = acc[ai][bj][m][0] * rs + bv[bj][0], v1 = acc[ai][bj][m][1] * rs + bv[bj][1];
#pragma unroll
                        for (int j = 0; j < 4; ++j) { v0[j] = sigmoidf_(v0[j]); v1[j] = sigmoidf_(v1[j]); }
                        *(gu32x4*)(rp + bj * 128) = pack8(v0, v1); } }
        }
    }
};
struct EpiBrA {
    static constexpr bool PERM = true, AFTER_DRAIN = false;
    const bf16_t* G; bf16_t* MP;
    __device__ __forceinline__ void operator()(const f32x4 (&acc)[2][2][4][2], const Unit& u, int wr, int wc, int fr, int fq) const {
        int cb = wc * 32 + 8 * fq; asm volatile("" : "+v"(cb), "+v"(fr)); cb += u.pn * 256;
#pragma unroll
        for (int ai = 0; ai < 2; ++ai)
#pragma unroll
            for (int m = 0; m < 4; ++m) { const int row = u.pm * 256 + ai * 128 + wr * 64 + m * 16 + fr;
#pragma unroll
                for (int bj = 0; bj < 2; ++bj) { const int col = cb + bj * 128; f32x4 g0, g1; unpack8(*(const gu32x4*)(G + (size_t)row * 2048 + col), g0, g1);
                    *(gu32x4*)(MP + (size_t)row * 1024 + col) = pack8(acc[ai][bj][m][0] * g0, acc[ai][bj][m][1] * g1); } }
    }
};
struct EpiBrB {
    static constexpr bool PERM = true, AFTER_DRAIN = false;
    const bf16_t* G; const bf16_t* MP; bf16_t* MG;
    __device__ __forceinline__ void operator()(const f32x4 (&acc)[2][2][4][2], const Unit& u, int wr, int wc, int fr, int fq) const {
        int cb = wc * 32 + 8 * fq; asm volatile("" : "+v"(cb), "+v"(fr)); cb += u.pn * 256;
#pragma unroll
        for (int ai = 0; ai < 2; ++ai)
#pragma unroll
            for (int m = 0; m < 4; ++m) { const int row = u.pm * 256 + ai * 128 + wr * 64 + m * 16 + fr;
#pragma unroll
                for (int bj = 0; bj < 2; ++bj) { const int col = cb + bj * 128; f32x4 g0, g1, p0, p1;
                    unpack8(*(const gu32x4*)(G + (size_t)row * 2048 + 1024 + col), g0, g1); unpack8(*(const gu32x4*)(MP + (size_t)row * 1024 + col), p0, p1);
                    *(gu32x4*)(MG + (size_t)row * 1024 + col) = pack8(p0 + acc[ai][bj][m][0] * g0, p1 + acc[ai][bj][m][1] * g1); } }
    }
};
struct EpiRes {
    static constexpr bool PERM = true, AFTER_DRAIN = false;
    const gfloat* xin; gfloat* xout; gfloat* xm; bf16_t* XB; gfloat* ssout;
    __device__ __forceinline__ void operator()(const f32x4 (&acc)[2][2][4][2], const Unit& u, int wr, int wc, int fr, int fq) const {
        int cb = wc * 32 + 8 * fq; asm volatile("" : "+v"(cb), "+v"(fr)); cb += u.pn * 256;
#pragma unroll
        for (int ai = 0; ai < 2; ++ai)
#pragma unroll
            for (int m = 0; m < 4; ++m) { const int row = u.pm * 256 + ai * 128 + wr * 64 + m * 16 + fr;
                const gfloat* ip; gfloat* op;
                if (u.pm < 64) { ip = xin + (size_t)row * 1024; op = xout + (size_t)row * 1024; } else { ip = xm + (size_t)(row - M_MAIN) * 1024; op = xm + (size_t)(row - M_MAIN) * 1024; }
                float sq = 0.f;
#pragma unroll
                for (int bj = 0; bj < 2; ++bj) { const int col = cb + bj * 128;
                    const f32x4 v0 = *(const gf32x4*)(ip + col) + acc[ai][bj][m][0], v1 = *(const gf32x4*)(ip + col + 4) + acc[ai][bj][m][1];
                    *(gf32x4*)(op + col) = v0; *(gf32x4*)(op + col + 4) = v1;
                    *(gu32x4*)(XB + (size_t)row * 1024 + col) = pack8(v0, v1);
                    sq += (v0[0] * v0[0] + v0[1] * v0[1]) + (v0[2] * v0[2] + v0[3] * v0[3]) + (v1[0] * v1[0] + v1[1] * v1[1]) + (v1[2] * v1[2] + v1[3] * v1[3]); }
                sq += __shfl_xor(sq, 16); sq += __shfl_xor(sq, 32);
                if (fq == 0) ssout[(size_t)u.pn * (M_PAD * 4) + (size_t)row * 4 + wc] = sq; }
    }
};
struct EpiFfn {
    static constexpr bool PERM = true, AFTER_DRAIN = false;
    const gfloat* ss; bf16_t* HM;
    __device__ __forceinline__ void operator()(const f32x4 (&acc)[2][2][4][2], const Unit& u, int wr, int wc, int fr, int fq) const {
        int cb = wc * 32 + 8 * fq; asm volatile("" : "+v"(cb), "+v"(fr)); cb += u.pn * 128;
#pragma unroll
        for (int ai = 0; ai < 2; ++ai)
#pragma unroll
            for (int m = 0; m < 4; ++m) { const int row = u.pm * 256 + ai * 128 + wr * 64 + m * 16 + fr; const float rs = row_rs(ss, row);
                f32x4 h[2];
#pragma unroll
                for (int n = 0; n < 2; ++n) { const f32x4 g = acc[ai][0][m][n] * rs, up = acc[ai][1][m][n] * rs;
#pragma unroll
                    for (int j = 0; j < 4; ++j) h[n][j] = g[j] * sigmoidf_(g[j]) * up[j]; }
                *(gu32x4*)(HM + (size_t)row * DFF + cb) = pack8(h[0], h[1]); }
    }
};
}

__device__ __forceinline__ float wave_sum(float v) {
#pragma unroll
    for (int o = 1; o < 64; o <<= 1) v += __shfl_xor(v, o);
    return v;
}
__device__ __forceinline__ void p0a_fold(const float* w_in, const float* mix, const float* scale, float* wut, int gtid, int nthr) {
    for (int o = gtid; o < DEPTH * 1024 * 512; o += nthr) {
        const int n = o & 511, k = (o >> 9) & 1023, l = o >> 19, g = n >> 7, d = n & 127;
        const float* wr = w_in + ((size_t)l * 1024 + k) * NIN + 1536 + g * 128;
        const float* mx = mix + ((size_t)(l * 4 + g) * 128) * 128 + d;
        float s = 0.f;
#pragma unroll 8
        for (int c = 0; c < 128; ++c) s += wr[c] * mx[(size_t)c * 128];
        wut[o] = s * scale[l * 512 + n];
    }
}
__device__ __forceinline__ void tr_item(const float* src, int ld, int c0, const float* gk, int k0, bf16* WT, int K, int drow0, LAS float* scr, int lane) {
#pragma unroll 8
    for (int i = 0; i < 32; ++i) { const int kk = 2 * i + (lane >> 5); float v = src[(size_t)(k0 + kk) * ld + c0 + (lane & 31)]; if (gk) v *= gk[k0 + kk]; scr[kk * 33 + (lane & 31)] = v; }
    LDS_WAIT(); asm volatile("" ::: "memory");
    const int c = lane & 7;
#pragma unroll
    for (int j = 0; j < 4; ++j) { const int n = (lane >> 3) + 8 * j; const LAS float* s = scr + (8 * c) * 33 + n;
        v4u o; o.x = pk2(s[0 * 33], s[1 * 33]); o.y = pk2(s[2 * 33], s[3 * 33]); o.z = pk2(s[4 * 33], s[5 * 33]); o.w = pk2(s[6 * 33], s[7 * 33]);
        *(GAS v4u*)(WT + (size_t)(drow0 + n) * K + k0 + 8 * c) = o; }
    LDS_WAIT(); asm volatile("" ::: "memory");
}
struct In14 { const float *x, *meta, *g1, *w_in, *b_gate, *mix, *scale, *wbp, *wbs, *wout, *g2, *wf1, *wf2, *gf; };
__device__ __forceinline__ void p0b_weights(const In14& I, unsigned char* ws, LAS float* scr, int gw, int ngw, int lane) {
    constexpr int I_IN = 16 * 128, I_BP = 8 * 32, I_OUT = 16 * 32, I_F1 = 16 * 176, I_F2 = 44 * 32, I_L = I_IN + 2 * I_BP + I_OUT + I_F1 + I_F2;
    for (int it = gw; it < DEPTH * I_L; it += ngw) {
        const int l = it / I_L; int r = it % I_L;
        if (r < I_IN) { const int kb = r >> 7, nb = r & 127, n0 = nb * 32; const bool fold = (n0 >= 1536 && n0 < 2048);
            const float* src = fold ? (const float*)(ws + WS_WUT) + (size_t)l * 1024 * 512 : I.w_in + (size_t)l * 1024 * NIN;
            tr_item(src, fold ? 512 : NIN, fold ? n0 - 1536 : n0, I.g1 + l * 1024, kb * 64, (bf16*)(ws + WS_WIN) + (size_t)l * NIN * 1024, 1024, n0, scr, lane); continue; }
        r -= I_IN;
        if (r < I_BP) { const int kb = r >> 5, nb = r & 31; tr_item(I.wbp + (size_t)l * 512 * 1024, 1024, nb * 32, nullptr, kb * 64, (bf16*)(ws + WS_WBP) + (size_t)l * 1024 * 512, 512, nb * 32, scr, lane); continue; }
        r -= I_BP;
        if (r < I_BP) { const int kb = r >> 5, nb = r & 31; tr_item(I.wbs + (size_t)l * 512 * 1024, 1024, nb * 32, nullptr, kb * 64, (bf16*)(ws + WS_WBS) + (size_t)l * 1024 * 512, 512, nb * 32, scr, lane); continue; }
        r -= I_BP;
        if (r < I_OUT) { const int kb = r >> 5, nb = r & 31; tr_item(I.wout + (size_t)l * 1024 * 1024, 1024, nb * 32, nullptr, kb * 64, (bf16*)(ws + WS_WOUT) + (size_t)l * 1024 * 1024, 1024, nb * 32, scr, lane); continue; }
        r -= I_OUT;
        if (r < I_F1) { const int kb = r / 176, jb = r % 176, j0 = jb * 32, pn = j0 >> 8, jj = j0 & 255; const int c0 = jj < 128 ? pn * 128 + jj : DFF + pn * 128 + (jj - 128);
            tr_item(I.wf1 + (size_t)l * 1024 * NF1, NF1, c0, I.g2 + l * 1024, kb * 64, (bf16*)(ws + WS_WF1) + (size_t)l * NF1 * 1024, 1024, j0, scr, lane); continue; }
        r -= I_F1;
        { const int kb = r >> 5, nb = r & 31; tr_item(I.wf2 + (size_t)l * DFF * 1024, 1024, nb * 32, nullptr, kb * 64, (bf16*)(ws + WS_WF2) + (size_t)l * 1024 * DFF, DFF, nb * 32, scr, lane); }
    }
}
__device__ __forceinline__ void p0b_rows(const In14& I, unsigned char* ws, int gw, int ngw, int lane) {
    for (int row = gw; row < M_PAD; row += ngw) {
        const float* src = row < M_MAIN ? I.x + (size_t)row * D : (row < M_MAIN + NMETA ? I.meta + (size_t)(row - M_MAIN) * D : nullptr);
        f32x4 v[4]; float s = 0.f;
#pragma unroll
        for (int j = 0; j < 4; ++j) { v[j] = src ? ((const GAS f32x4*)src)[64 * j + lane] : (f32x4){0.f, 0.f, 0.f, 0.f}; s += (v[j].x * v[j].x + v[j].y * v[j].y) + (v[j].z * v[j].z + v[j].w * v[j].w); }
        s = wave_sum(s);
        GAS unsigned long long* o8 = (GAS unsigned long long*)((bf16*)(ws + WS_XB) + (size_t)row * D) + lane;
#pragma unroll
        for (int j = 0; j < 4; ++j) o8[64 * j] = (unsigned long long)pk2(v[j].x, v[j].y) | ((unsigned long long)pk2(v[j].z, v[j].w) << 32);
        if (lane < 16) ((float*)(ws + WS_SSA))[(size_t)(lane >> 2) * (M_PAD * 4) + (size_t)row * 4 + (lane & 3)] = lane == 0 ? s : 0.f;
        if (row >= M_MAIN) { GAS f32x4* xm = (GAS f32x4*)((float*)(ws + WS_XM) + (size_t)(row - M_MAIN) * D);
#pragma unroll
            for (int j = 0; j < 4; ++j) xm[64 * j + lane] = v[j]; }
    }
}
__device__ __forceinline__ float bf_lo(unsigned w) { return __uint_as_float(w << 16); }
__device__ __forceinline__ float bf_hi(unsigned w) { return __uint_as_float(w & 0xffff0000u); }
__device__ __forceinline__ void pool_filter(const bf16* U, bf16* A, int gtid, int nthr) {
    for (int w = gtid; w < (M_MAIN + NMETA) * 64; w += nthr) {
        const int c8 = w & 63, i = w >> 6; int b, p;
        if (i < M_MAIN) { b = i >> 11; p = NMETA + (i & 2047); } else { b = 0; p = i - M_MAIN; }
        const int win = 2 << (c8 >> 4), cnt = (p + 1 < win) ? p + 1 : win;
        const bf16* up = U + (size_t)(b * LTOT + p) * 512 + c8 * 8;
        float a[8], cur[8];
#pragma unroll
        for (int e = 0; e < 8; ++e) a[e] = 0.f;
        for (int j = 0; j < cnt; ++j) { const v4u v = *(const GAS v4u*)(up - (size_t)j * 512);
            const float f[8] = {bf_lo(v.x), bf_hi(v.x), bf_lo(v.y), bf_hi(v.y), bf_lo(v.z), bf_hi(v.z), bf_lo(v.w), bf_hi(v.w)};
#pragma unroll
            for (int e = 0; e < 8; ++e) { a[e] += f[e]; if (j == 0) cur[e] = f[e]; } }
        const float inv = 1.0f / (float)cnt;
        v4u o; o.x = pk2(a[0] * inv - cur[0], a[1] * inv - cur[1]); o.y = pk2(a[2] * inv - cur[2], a[3] * inv - cur[3]);
        o.z = pk2(a[4] * inv - cur[4], a[5] * inv - cur[5]); o.w = pk2(a[6] * inv - cur[6], a[7] * inv - cur[7]);
        *(GAS v4u*)(A + (size_t)i * 512 + c8 * 8) = o;
    }
}
__device__ __forceinline__ void attn_simple(const bf16* Q, const bf16* K, const bf16* V, bf16* S, int gw, int ngw, int lane) {
    for (int it = gw; it < NB * NH * (SEQ / 64) + NH; it += ngw) {
        int b, h, p, qrow, smax;
        if (it < NB * NH * (SEQ / 64)) { const int bh = it >> 5, qc = it & 31; b = bh >> 3; h = bh & 7; const int t = qc * 64 + lane; p = NMETA + t; qrow = b * SEQ + t; smax = NMETA + qc * 64 + 63; }
        else { h = it - NB * NH * (SEQ / 64); b = 0; p = lane < NMETA ? lane : 0; qrow = M_MAIN + (lane < NMETA ? lane : 0); smax = NMETA; }
        float q[64], o[64];
        { const GAS v4u* qp = (const GAS v4u*)(Q + (size_t)qrow * 512 + h * 64);
#pragma unroll
          for (int c = 0; c < 8; ++c) { const v4u v = qp[c]; q[8 * c + 0] = bf_lo(v.x); q[8 * c + 1] = bf_hi(v.x); q[8 * c + 2] = bf_lo(v.y); q[8 * c + 3] = bf_hi(v.y); q[8 * c + 4] = bf_lo(v.z); q[8 * c + 5] = bf_hi(v.z); q[8 * c + 6] = bf_lo(v.w); q[8 * c + 7] = bf_hi(v.w); } }
#pragma unroll
        for (int d = 0; d < 64; ++d) o[d] = 0.f;
        float I = 1.0f;
        for (int s = smax - 1; s >= 0; --s) {
#if EARLY_EXIT
            if (!__any(I != 0.0f)) break;
#endif
            int soff = (b * LTOT + s) * 512 + h * 64; asm volatile("" : "+v"(soff));
            const GAS v4u* kp = (const GAS v4u*)(K + soff); const GAS v4u* vp = (const GAS v4u*)(V + soff);
            float z = 0.f;
#pragma unroll
            for (int c = 0; c < 8; ++c) { const v4u v = kp[c];
                z += q[8 * c + 0] * bf_lo(v.x) + q[8 * c + 1] * bf_hi(v.x) + q[8 * c + 2] * bf_lo(v.y) + q[8 * c + 3] * bf_hi(v.y) + q[8 * c + 4] * bf_lo(v.z) + q[8 * c + 5] * bf_hi(v.z) + q[8 * c + 6] * bf_lo(v.w) + q[8 * c + 7] * bf_hi(v.w); }
            float m = __builtin_amdgcn_rcpf(1.0f + __builtin_amdgcn_exp2f(z));
            if (s >= p) m = 1.0f;
            const float In = I * m, w = I - In; I = In;
#pragma unroll
            for (int c = 0; c < 8; ++c) { const v4u v = vp[c];
                o[8 * c + 0] += w * bf_lo(v.x); o[8 * c + 1] += w * bf_hi(v.x); o[8 * c + 2] += w * bf_lo(v.y); o[8 * c + 3] += w * bf_hi(v.y); o[8 * c + 4] += w * bf_lo(v.z); o[8 * c + 5] += w * bf_hi(v.z); o[8 * c + 6] += w * bf_lo(v.w); o[8 * c + 7] += w * bf_hi(v.w); }
        }
        if (it < NB * NH * (SEQ / 64) || lane < NMETA) { GAS v4u* sp = (GAS v4u*)(S + (size_t)qrow * 512 + h * 64);
#pragma unroll
            for (int c = 0; c < 8; ++c) { v4u w; w.x = pk2(o[8 * c + 0], o[8 * c + 1]); w.y = pk2(o[8 * c + 2], o[8 * c + 3]); w.z = pk2(o[8 * c + 4], o[8 * c + 5]); w.w = pk2(o[8 * c + 6], o[8 * c + 7]); sp[c] = w; } }
    }
}
__device__ __forceinline__ void final_norm(float* out, const float* gf, int gw, int ngw, int lane) {
    f32x4 g[4];
#pragma unroll
    for (int j = 0; j < 4; ++j) g[j] = ((const GAS f32x4*)gf)[64 * j + lane];
    for (int row = gw; row < M_MAIN; row += ngw) {
        GAS f32x4* xr = (GAS f32x4*)(out + (size_t)row * D); f32x4 v[4]; float s = 0.f;
#pragma unroll
        for (int j = 0; j < 4; ++j) { v[j] = xr[64 * j + lane]; s += (v[j].x * v[j].x + v[j].y * v[j].y) + (v[j].z * v[j].z + v[j].w * v[j].w); }
        const float rs = 1.0f / sqrtf(wave_sum(s) * (1.0f / D) + RMS_EPS);
#pragma unroll
        for (int j = 0; j < 4; ++j) xr[64 * j + lane] = v[j] * rs * g[j];
    }
}

constexpr int N_PHASES = 15;
struct Args { const float* in[14]; float* out; unsigned char* ws; int ph_lo, ph_hi; };
__global__ void __launch_bounds__(NWAVES * 64, 2) fwd_kernel(Args args) {
    extern __shared__ __attribute__((aligned(16))) unsigned char lds[];
    LAS unsigned char* L = (LAS unsigned char*)lds;
    volatile LAS unsigned* MISC = (volatile LAS unsigned*)(L + MISC_OFF);
    const int tid = threadIdx.x, lane = tid & 63, wave = __builtin_amdgcn_readfirstlane(tid >> 6);
    const int G = gridDim.x, bx = blockIdx.x, vcu = (G % 8 == 0) ? (bx % 8) * (G / 8) + bx / 8 : bx;
    const int gw = vcu * NWAVES + wave, ngw = G * NWAVES, gtid = bx * (NWAVES * 64) + tid, nthr = G * NWAVES * 64;
    unsigned char* ws = args.ws;
    gu32* ctl = (gu32*)(ws + WS_CTL);
    In14 I; I.x = args.in[0]; I.meta = args.in[1]; I.g1 = args.in[2]; I.w_in = args.in[3]; I.b_gate = args.in[4]; I.mix = args.in[5]; I.scale = args.in[6];
    I.wbp = args.in[7]; I.wbs = args.in[8]; I.wout = args.in[9]; I.g2 = args.in[10]; I.wf1 = args.in[11]; I.wf2 = args.in[12]; I.gf = args.in[13];
    float* out = args.out;
    for (int u = tid; u < (LDS_BYTES - LDSCTL_OFF) / 4; u += NWAVES * 64) ((LAS unsigned*)(L + LDSCTL_OFF))[u] = 0u;
    __syncthreads();
    const int lo = args.ph_lo, hi = args.ph_hi;
    const bool multi = (hi - lo) > 1;
    XcdBarrier bar; bar.bar = (unsigned*)(ctl + CW_BAR); bar.x = 0; bar.st = nullptr;
    if (multi) bar = xcd_barrier_post((unsigned*)(ctl + CW_BAR), MISC + 8);
#define IN(k) (lo <= (k) && (k) < hi)
#define SEAM(k) do { if (IN(k) && IN((k) + 1)) xcd_barrier(bar); } while (0)
    if (IN(0)) { p0a_fold(I.w_in, I.mix, I.scale, (float*)(ws + WS_WUT), gtid, nthr); }
    SEAM(0);
    if (IN(1)) { p0b_weights(I, ws, (LAS float*)(L + RING_OFF + wave * 16384), gw, ngw, lane); p0b_rows(I, ws, gw, ngw, lane); }
    SEAM(1);
    for (int l = 0; l < DEPTH; ++l) {
        const int pb = 2 + 6 * l;
        unsigned char* w = ws; int bxl = bx, Gl = G; asm volatile("" : "+s"(w), "+s"(bxl), "+s"(Gl));
#define WB(off) ((bf16*)(w + (off)))
#define WG(off) ((GAS bf16*)(w + (off)))
#define WF(off) ((GAS float*)(w + (off)))
        if (IN(pb + 0)) {
            pg8::Gemm g{WB(WS_XB), WB(WS_WIN) + (size_t)l * NIN * 1024, M_PAD, NIN, 1024}; pg8::StaticOrder S; S.init(M_PAD, NIN, Gl, bxl);
            epi::EpiIn E{WG(WS_Q), WG(WS_U), WG(WS_G), WF(WS_SSA), (const GAS float*)(I.b_gate + l * 2048)};
            pg8::gemm_phase<epi::EpiIn, pg8::StaticOrder, PG8_ALIGN, PG8_SP2>(L + RING_OFF, g, S, E);
        }
        SEAM(pb + 0);
        if (IN(pb + 1)) { pool_filter(WB(WS_U), WB(WS_A), gtid, nthr); attn_simple(WB(WS_Q), WB(WS_K), WB(WS_V), WB(WS_S), gw, ngw, lane); }
        SEAM(pb + 1);
        if (IN(pb + 2)) {
            { pg8::Gemm g{WB(WS_A), WB(WS_WBP) + (size_t)l * 1024 * 512, M_PAD, 1024, 512}; pg8::StaticOrder S; S.init(M_PAD, 1024, Gl, bxl);
              epi::EpiBrA E{WG(WS_G), WG(WS_MP)}; pg8::gemm_phase<epi::EpiBrA, pg8::StaticOrder, PG8_ALIGN, PG8_SP2>(L + RING_OFF, g, S, E); }
            { pg8::Gemm g{WB(WS_S), WB(WS_WBS) + (size_t)l * 1024 * 512, M_PAD, 1024, 512}; pg8::StaticOrder S; S.init(M_PAD, 1024, Gl, bxl);
              epi::EpiBrB E{WG(WS_G), WG(WS_MP), WG(WS_MG)}; pg8::gemm_phase<epi::EpiBrB, pg8::StaticOrder, PG8_ALIGN, PG8_SP2>(L + RING_OFF, g, S, E); }
        }
        SEAM(pb + 2);
        if (IN(pb + 3)) {
            pg8::Gemm g{WB(WS_MG), WB(WS_WOUT) + (size_t)l * 1024 * 1024, M_PAD, 1024, 1024}; pg8::StaticOrder S; S.init(M_PAD, 1024, Gl, bxl);
            epi::EpiRes E{(const GAS float*)(l == 0 ? I.x : out), (GAS float*)out, WF(WS_XM), WG(WS_XB), WF(WS_SSB)};
            pg8::gemm_phase<epi::EpiRes, pg8::StaticOrder, PG8_ALIGN, PG8_SP2>(L + RING_OFF, g, S, E);
        }
        SEAM(pb + 3);
        if (IN(pb + 4)) {
            pg8::Gemm g{WB(WS_XB), WB(WS_WF1) + (size_t)l * NF1 * 1024, M_PAD, NF1, 1024}; pg8::StaticOrder S; S.init(M_PAD, NF1, Gl, bxl);
            epi::EpiFfn E{WF(WS_SSB), WG(WS_HM)};
            pg8::gemm_phase<epi::EpiFfn, pg8::StaticOrder, PG8_ALIGN, PG8_SP2>(L + RING_OFF, g, S, E);
        }
        SEAM(pb + 4);
        if (IN(pb + 5)) {
            pg8::Gemm g{WB(WS_HM), WB(WS_WF2) + (size_t)l * 1024 * DFF, M_PAD, 1024, DFF}; pg8::StaticOrder S; S.init(M_PAD, 1024, Gl, bxl);
            epi::EpiRes E{(const GAS float*)out, (GAS float*)out, WF(WS_XM), WG(WS_XB), WF(WS_SSA)};
            pg8::gemm_phase<epi::EpiRes, pg8::StaticOrder, PG8_ALIGN, PG8_SP2>(L + RING_OFF, g, S, E);
        }
        SEAM(pb + 5);
#undef WB
#undef WG
#undef WF
    }
    if (IN(14)) final_norm(out, I.gf, gw, ngw, lane);
#undef IN
#undef SEAM
}

#if defined(DUMP_AFTER)
#ifndef DUMP_LIST
#define DUMP_LIST {WS_G, (size_t)M_PAD * 2048}, {WS_Q, (size_t)M_PAD * 512}, {WS_K, (size_t)NB * LTOT * 512}, {WS_V, (size_t)NB * LTOT * 512}, {WS_U, (size_t)NB * LTOT * 512}
#endif
#ifndef DUMP_F32
#define DUMP_F32 {WS_SSA, (size_t)M_PAD * 16}
#endif
#ifndef DUMP_FSCALE
#define DUMP_FSCALE 0.f
#endif
struct DumpEnt { size_t off, cnt; };
__global__ void dump_kernel(const unsigned char* ws, float* out) {
    const DumpEnt L[] = {DUMP_LIST}; const DumpEnt F[] = {DUMP_F32};
    for (size_t i = (size_t)blockIdx.x * blockDim.x + threadIdx.x; i < (size_t)M_MAIN * D; i += (size_t)gridDim.x * blockDim.x) {
        float v = 0.f;
        for (unsigned j = 0; j < sizeof(L) / sizeof(L[0]); ++j) { const unsigned short h = ((const unsigned short*)(ws + L[j].off))[i % L[j].cnt]; v += __uint_as_float((unsigned)h << 16); }
        for (unsigned j = 0; j < sizeof(F) / sizeof(F[0]); ++j) v += DUMP_FSCALE * ((const float*)(ws + F[j].off))[i % F[j].cnt];
        out[i] = v;
    }
}
#endif
#ifndef MK_LAUNCH_PER_PHASE
#define MK_LAUNCH_PER_PHASE 1
#endif
extern "C" void kernel_launch(void* const* d_in, const int* in_sizes, int n_in, void* d_out, int out_size, void* d_ws, size_t ws_size, hipStream_t stream) {
    static int grid = 0;
    if (grid == 0) {
        if (n_in != 14 || in_sizes[0] != M_MAIN * D || out_size != M_MAIN * D || ws_size < WS_WUT + 4 * MiB) { fprintf(stderr, "kernel_launch: unexpected shapes: n_in %d in0 %d out %d ws %zu (need %zu)\n", n_in, n_in > 0 ? in_sizes[0] : -1, out_size, ws_size, (size_t)WS_END); grid = -1; return; }
        int dev = 0, cus = 0, per_cu = 0;
        if (hipGetDevice(&dev) != hipSuccess || hipDeviceGetAttribute(&cus, hipDeviceAttributeMultiprocessorCount, dev) != hipSuccess) { fprintf(stderr, "kernel_launch: device query failed\n"); grid = -1; return; }
        if (hipFuncSetAttribute((const void*)fwd_kernel, hipFuncAttributeMaxDynamicSharedMemorySize, LDS_BYTES) != hipSuccess) { fprintf(stderr, "kernel_launch: hipFuncSetAttribute failed\n"); grid = -1; return; }
        if (hipOccupancyMaxActiveBlocksPerMultiprocessor(&per_cu, (const void*)fwd_kernel, NWAVES * 64, LDS_BYTES) != hipSuccess || per_cu < 1)
            fprintf(stderr, "kernel_launch: note: occupancy query reports %d workgroups per CU\n", per_cu);
        (void)hipGetLastError();
        grid = cus;
    }
    if (grid < 0) return;
    if (hipMemsetAsync((char*)d_ws + WS_CTL, 0, CTL_ZERO_BYTES, stream) != hipSuccess) { fprintf(stderr, "kernel_launch: memset failed\n"); return; }
    Args a{};
    for (int i = 0; i < 14; ++i) a.in[i] = (const float*)d_in[i];
    a.out = (float*)d_out; a.ws = (unsigned char*)d_ws;
#if defined(DUMP_AFTER)
    for (int p = 0; p <= DUMP_AFTER; ++p) { a.ph_lo = p; a.ph_hi = p + 1; hipLaunchKernelGGL(fwd_kernel, dim3(grid), dim3(NWAVES * 64), LDS_BYTES, stream, a); }
    hipLaunchKernelGGL(dump_kernel, dim3(2048), dim3(256), 0, stream, (const unsigned char*)d_ws, (float*)d_out);
#elif MK_LAUNCH_PER_PHASE
    for (int p = 0; p < N_PHASES; ++p) { a.ph_lo = p; a.ph_hi = p + 1; hipLaunchKernelGGL(fwd_kernel, dim3(grid), dim3(NWAVES * 64), LDS_BYTES, stream, a); }
#else
    a.ph_lo = 0; a.ph_hi = N_PHASES; hipLaunchKernelGGL(fwd_kernel, dim3(grid), dim3(NWAVES * 64), LDS_BYTES, stream, a);
#endif
    const hipError_t le = hipPeekAtLastError();
    if (le != hipSuccess) fprintf(stderr, "kernel_launch: launch failed: %s\n", hipGetErrorName(le));
}
```

```cpp
#define MK_LAUNCH_PER_PHASE 0
#include <hip/hip_runtime.h>
#include <cstdio>
#include <cstdint>
namespace pg8 {
#define PG8_LAS __attribute__((address_space(3)))
typedef unsigned short bf16_t;
typedef short bf16x8 __attribute__((ext_vector_type(8)));
typedef float f32x4 __attribute__((ext_vector_type(4)));
typedef unsigned u32x4 __attribute__((ext_vector_type(4)));
constexpr int BM = 256, BK = 64, HALF = 128, HTB = HALF * BK * 2  , STAGE_BYTES = 8 * HTB, NXCD = 8, WGM = 8;

__host__ __device__ __forceinline__ int lds_byte(int r, int c) { const int st = (r >> 4) * 2 + (c >> 5), rr = r & 15, cc = c & 31, ob = rr * 64 + cc * 2; return st * 1024 + (ob ^ (((ob >> 9) & 1) << 5)); }
__host__ __device__ __forceinline__ void stage_rc(int b, int& R, int& C) { const int st = b / 1024, sb = b % 1024, swz = sb ^ (((sb >> 9) & 1) << 5); R = (st >> 1) * 16 + swz / 64; C = (st & 1) * 32 + (swz % 64) / 2; }
__host__ __device__ __forceinline__ int perm32(int rho) { const int n = rho >> 4, i = rho & 15; return 8 * (i >> 2) + 4 * n + (i & 3); }

struct Unit { int pm, pn; };
struct Gemm { const bf16_t* A; const bf16_t* Bt; int M, N, K; };

struct StaticOrder {
    int nM, nN, nwg, G, c;
    __host__ __device__ void init(int M, int N, int G_, int c_) { nM = M / BM; nN = N / BM; nwg = nM * nN; G = G_; c = c_; }
    __host__ __device__ bool next(int i, Unit& u) const {
        const long L = (long)i * G + c; if (L >= nwg) return false;
        int wgid = (int)L; { const int q = nwg / NXCD, r = nwg % NXCD, xcd = wgid % NXCD, off = wgid / NXCD; wgid = (xcd < r ? xcd * (q + 1) : r * (q + 1) + (xcd - r) * q) + off; }
        const int nig = WGM * nN, gid = wgid / nig, fm = gid * WGM, gsz = (nM - fm) < WGM ? (nM - fm) : WGM;
        u.pm = fm + ((wgid % nig) % gsz); u.pn = (wgid % nig) / gsz; return true;
    }
    __device__ __forceinline__ void a_ready(const Unit&) const {}
    __device__ __forceinline__ void done(const Unit&) const {}
};

__device__ __forceinline__ unsigned cvt_pk_bf16(float lo, float hi) { unsigned r; asm volatile("v_cvt_pk_bf16_f32 %0, %1, %2" : "=v"(r) : "v"(lo), "v"(hi)); return r; }
template <class Epi, class Sched, bool ALIGN_EPI = false, bool SP2 = false>
__device__ __forceinline__ void gemm_phase(PG8_LAS unsigned char* lds, const Gemm g, const Sched& S, const Epi& E) {
    int tid = threadIdx.x; asm volatile("" : "+v"(tid));
    const int wid = __builtin_amdgcn_readfirstlane(tid >> 6), lane = tid & 63, wr = wid >> 2, wc = wid & 3, fr = lane & 15, fq = lane >> 4;
    const int K = g.K, nt = K / BK;
    unsigned voffA[2], voffB[2];
#pragma unroll
    for (int i = 0; i < 2; ++i) { int R, C; stage_rc(tid * 16 + i * 8192, R, C); const int Rb = Epi::PERM ? ((R & ~31) + perm32(R & 31)) : R;
        voffA[i] = (unsigned)(R * K + C) * 2u; voffB[i] = (unsigned)(Rb * K + C) * 2u; }
    const size_t kstep = (size_t)(BK * 2);
    const size_t hstep = (size_t)HALF * K * 2;
    const size_t tstep = 2 * hstep;
    const unsigned ldsw = (unsigned)wid * 1024u;
    const int aoff = lds_byte(wr * 64 + fr, fq * 8), boff = lds_byte(wc * 32 + fr, fq * 8);
#define PG8_SA(b, h) (((b) * 2 + (h)) * HTB)
#define PG8_SB(b, h) ((4 + (b) * 2 + (h)) * HTB)
#define PG8_STAGE(bufoff, gbase, voff) do { _Pragma("unroll") for (int _i = 0; _i < 2; ++_i) \
        __builtin_amdgcn_global_load_lds((const unsigned*)((const char*)(gbase) + (voff)[_i]), (PG8_LAS unsigned*)(lds + (bufoff) + ldsw + _i * 8192), 16, 0, 0); } while (0)
#define PG8_LDA(dst, b, h) do { _Pragma("unroll") for (int m = 0; m < 4; ++m) _Pragma("unroll") for (int k = 0; k < 2; ++k) dst[m][k] = *(const PG8_LAS bf16x8*)(lds + PG8_SA(b, h) + aoff + m * 2048 + k * 1024); } while (0)
#define PG8_LDB(dst, b, h) do { _Pragma("unroll") for (int n = 0; n < 2; ++n) _Pragma("unroll") for (int k = 0; k < 2; ++k) dst[n][k] = *(const PG8_LAS bf16x8*)(lds + PG8_SB(b, h) + boff + n * 2048 + k * 1024); } while (0)
#define PG8_MMA(ai, bj, At, Bt) do { __builtin_amdgcn_s_setprio(1); _Pragma("unroll") for (int m = 0; m < 4; ++m) _Pragma("unroll") for (int n = 0; n < 2; ++n) _Pragma("unroll") for (int k = 0; k < 2; ++k) \
        acc[ai][bj][m][n] = __builtin_amdgcn_mfma_f32_16x16x32_bf16(Bt[n][k], At[m][k], acc[ai][bj][m][n], 0, 0, 0); __builtin_amdgcn_s_setprio(0); } while (0)
#define PG8_WAIT_V(n) asm volatile("s_waitcnt vmcnt(" #n ")" ::: "memory")
#define PG8_WAIT_L(n) asm volatile("s_waitcnt lgkmcnt(" #n ")" ::: "memory")
#define PG8_BAR __builtin_amdgcn_s_barrier()
#define PG8_SCHED __builtin_amdgcn_sched_barrier(0)
    Unit cur, nxt; int ui = 0;
    if (!S.next(0, cur)) return;
    f32x4 acc[2][2][4][2];
#pragma unroll
    for (int a = 0; a < 2; ++a)
#pragma unroll
        for (int b = 0; b < 2; ++b)
#pragma unroll
            for (int m = 0; m < 4; ++m)
#pragma unroll
                for (int n = 0; n < 2; ++n) acc[a][b][m][n] = (f32x4){0.f, 0.f, 0.f, 0.f};
    bf16x8 At[4][2], B0[2][2], B1[2][2];
    const char* cA = (const char*)g.A + (size_t)cur.pm * tstep; const char* cB = (const char*)g.Bt + (size_t)cur.pn * tstep;
    S.a_ready(cur);
    if constexpr (SP2) {
        PG8_STAGE(PG8_SB(0, 0), cB, voffB); PG8_STAGE(PG8_SB(0, 1), cB + hstep, voffB); PG8_STAGE(PG8_SA(0, 0), cA, voffA); PG8_STAGE(PG8_SA(0, 1), cA + hstep, voffA);
        if (wr == 1) PG8_BAR;
        PG8_WAIT_V(2); PG8_BAR;
        PG8_STAGE(PG8_SB(1, 0), cB + kstep, voffB); PG8_STAGE(PG8_SA(1, 0), cA + kstep, voffA); PG8_STAGE(PG8_SB(1, 1), cB + hstep + kstep, voffB);
        PG8_WAIT_V(6); PG8_BAR;
    } else {
        PG8_STAGE(PG8_SB(0, 0), cB, voffB); PG8_STAGE(PG8_SA(0, 0), cA, voffA); PG8_STAGE(PG8_SB(0, 1), cB + hstep, voffB); PG8_STAGE(PG8_SA(0, 1), cA + hstep, voffA);
        if (wr == 1) PG8_BAR;
        PG8_WAIT_V(4); PG8_BAR;
        PG8_STAGE(PG8_SB(1, 0), cB + kstep, voffB); PG8_STAGE(PG8_SA(1, 0), cA + kstep, voffA); PG8_STAGE(PG8_SB(1, 1), cB + hstep + kstep, voffB);
        PG8_WAIT_V(6); PG8_BAR;
    }
    for (;;) {
        const bool has_next = S.next(ui + 1, nxt);
        const char* nA = has_next ? (const char*)g.A + (size_t)nxt.pm * tstep : cA; const char* nB = has_next ? (const char*)g.Bt + (size_t)nxt.pn * tstep : cB;
        for (int t = 0; t < nt; t += 2) {
            const bool last = (t == nt - 2);
            const char* a1 = cA + (size_t)(t + 1) * kstep;
            const char* a2 = last ? nA : cA + (size_t)(t + 2) * kstep; const char* b2 = last ? nB : cB + (size_t)(t + 2) * kstep;
            const char* a3 = a2 + kstep; const char* b3 = b2 + kstep;
            if (last && has_next) S.a_ready(nxt);
            if constexpr (SP2) {
            PG8_LDB(B0, 0, 0); PG8_LDB(B1, 0, 1); PG8_SCHED; PG8_LDA(At, 0, 0); PG8_STAGE(PG8_SA(1, 1), a1 + hstep, voffA);
            PG8_WAIT_V(8); PG8_WAIT_L(0); PG8_BAR; PG8_MMA(0, 0, At, B0); PG8_MMA(0, 1, At, B1); PG8_BAR; PG8_SCHED;
            PG8_LDA(At, 0, 1); PG8_STAGE(PG8_SB(0, 0), b2, voffB); PG8_STAGE(PG8_SB(0, 1), b2 + hstep, voffB); PG8_STAGE(PG8_SA(0, 0), a2, voffA);
            PG8_WAIT_V(8); PG8_WAIT_L(0); PG8_BAR; PG8_MMA(1, 0, At, B0); PG8_MMA(1, 1, At, B1); PG8_BAR; PG8_SCHED;
            PG8_LDB(B0, 1, 0); PG8_LDB(B1, 1, 1); PG8_SCHED; PG8_LDA(At, 1, 0); PG8_STAGE(PG8_SA(0, 1), a2 + hstep, voffA);
            PG8_WAIT_V(8); PG8_WAIT_L(0); PG8_BAR; PG8_MMA(0, 0, At, B0); PG8_MMA(0, 1, At, B1); PG8_BAR; PG8_SCHED;
            PG8_LDA(At, 1, 1); PG8_STAGE(PG8_SB(1, 0), b3, voffB); PG8_STAGE(PG8_SB(1, 1), b3 + hstep, voffB); PG8_STAGE(PG8_SA(1, 0), a3, voffA);
            PG8_WAIT_V(8); PG8_WAIT_L(0); PG8_BAR; PG8_MMA(1, 0, At, B0); PG8_MMA(1, 1, At, B1); PG8_BAR; PG8_SCHED;
            } else {
            PG8_LDB(B0, 0, 0); PG8_SCHED; PG8_LDA(At, 0, 0); PG8_STAGE(PG8_SA(1, 1), a1 + hstep, voffA);
            PG8_WAIT_L(8); PG8_BAR; PG8_WAIT_L(0); PG8_MMA(0, 0, At, B0); PG8_BAR; PG8_SCHED;
            PG8_LDB(B1, 0, 1); PG8_STAGE(PG8_SB(0, 0), b2, voffB);
            PG8_BAR; PG8_WAIT_L(0); PG8_MMA(0, 1, At, B1); PG8_BAR;
            PG8_LDA(At, 0, 1); PG8_STAGE(PG8_SA(0, 0), a2, voffA);
            PG8_BAR; PG8_WAIT_L(0); PG8_MMA(1, 0, At, B0); PG8_BAR; PG8_SCHED;
            PG8_STAGE(PG8_SB(0, 1), b2 + hstep, voffB);
            PG8_WAIT_V(6); PG8_BAR; PG8_MMA(1, 1, At, B1); PG8_BAR;
            PG8_LDB(B0, 1, 0); PG8_SCHED; PG8_LDA(At, 1, 0); PG8_STAGE(PG8_SA(0, 1), a2 + hstep, voffA);
            PG8_WAIT_L(8); PG8_BAR; PG8_WAIT_L(0); PG8_MMA(0, 0, At, B0); PG8_BAR; PG8_SCHED;
            PG8_LDB(B1, 1, 1); PG8_STAGE(PG8_SB(1, 0), b3, voffB);
            PG8_BAR; PG8_WAIT_L(0); PG8_MMA(0, 1, At, B1); PG8_BAR;
            PG8_LDA(At, 1, 1); PG8_STAGE(PG8_SA(1, 0), a3, voffA);
            PG8_BAR; PG8_WAIT_L(0); PG8_MMA(1, 0, At, B0); PG8_BAR; PG8_SCHED;
            PG8_STAGE(PG8_SB(1, 1), b3 + hstep, voffB);
            PG8_WAIT_V(6); PG8_BAR; PG8_MMA(1, 1, At, B1); PG8_BAR;
            }
        }
        if constexpr (ALIGN_EPI) { if (wr == 0) PG8_BAR; }
        if constexpr (!Epi::AFTER_DRAIN) { E(acc, cur, wr, wc, fr, fq); S.done(cur); }
        if (!has_next) break;
#pragma unroll
        for (int a = 0; a < 2; ++a)
#pragma unroll
            for (int b = 0; b < 2; ++b)
#pragma unroll
                for (int m = 0; m < 4; ++m)
#pragma unroll
                    for (int n = 0; n < 2; ++n) acc[a][b][m][n] = (f32x4){0.f, 0.f, 0.f, 0.f};
        cur = nxt; cA = nA; cB = nB; ++ui;
        if constexpr (ALIGN_EPI) { if (wr == 1) PG8_BAR; }
    }
    PG8_WAIT_V(0);
    if constexpr (!ALIGN_EPI) { if (wr == 0) PG8_BAR; }
    PG8_BAR;
    if constexpr (Epi::AFTER_DRAIN) { E.fused(acc, cur, wr, wc, fr, fq, lds, wid, lane); S.done(cur); }
#undef PG8_SA
#undef PG8_SB
#undef PG8_STAGE
#undef PG8_LDA
#undef PG8_LDB
#undef PG8_MMA
#undef PG8_WAIT_V
#undef PG8_WAIT_L
#undef PG8_BAR
#undef PG8_SCHED
}
}

#ifndef PG8_SP2
#define PG8_SP2 true
#endif
#ifndef PG8_ALIGN
#define PG8_ALIGN true
#endif

constexpr int NWAVES = 8;
constexpr int D = 1024, NB = 8, SEQ = 2048, NMETA = 16, LTOT = SEQ + NMETA, DEPTH = 2;
constexpr int M_MAIN = NB * SEQ;
constexpr int M_PAD = M_MAIN + 256;
constexpr int NIN = 4096, NH = 8, HD = 64, DFF = 2816, NF1 = 2 * DFF;
constexpr float RMS_EPS = 1e-6f;
constexpr float LOG2E = 1.4426950408889634f;
constexpr float QSCALE = 0.125f * LOG2E;
#ifndef EARLY_EXIT
#define EARLY_EXIT 1
#endif

constexpr size_t MiB = 1u << 20;
constexpr size_t WS_CTL = 0, CTL_ZERO_BYTES = 1 * MiB;
constexpr size_t WS_WIN = 1 * MiB;
constexpr size_t WS_WBP = 17 * MiB;
constexpr size_t WS_WBS = 19 * MiB;
constexpr size_t WS_WOUT = 21 * MiB;
constexpr size_t WS_WF1 = 25 * MiB;
constexpr size_t WS_WF2 = 47 * MiB;
constexpr size_t WS_SSA = 58 * MiB;
constexpr size_t WS_SSB = WS_SSA + 1280 * 1024;
constexpr size_t WS_XM = WS_SSB + 1280 * 1024;
constexpr size_t WS_XB = 62 * MiB;
constexpr size_t ACT16 = (size_t)M_PAD * 512 * 2;
constexpr size_t WS_A = WS_XB, WS_S = WS_XB + ACT16;
constexpr size_t WS_Q = WS_XB + 2 * ACT16;
constexpr size_t WS_U = WS_Q + ACT16, WS_K = WS_U + ACT16, WS_V = WS_K + ACT16, WS_G = WS_V + ACT16;
static_assert(WS_K == WS_U + ACT16 && WS_V == WS_U + 2 * ACT16, "EpiIn addresses K and V relative to U");
constexpr size_t WS_MP = WS_Q, WS_MG = WS_K, WS_HM = WS_Q;
constexpr size_t WS_END = WS_G + 4 * ACT16;
constexpr size_t WS_WUT = WS_END;
static_assert(WS_XM + 1 * MiB <= WS_XB && WS_WF2 + 11 * MiB <= WS_SSA && WS_WUT + 4 * MiB <= 256 * MiB, "d_ws map");
static_assert(WS_HM + (size_t)M_PAD * DFF * 2 <= WS_END, "HM overlay");
constexpr int CW_TMO = 0, CW_CODE = 1;
constexpr int CW_BAR = 4096;

constexpr int RING_OFF = 0, RING_BYTES = 131072;
constexpr int LDSCTL_OFF = RING_BYTES, MISC_OFF = LDSCTL_OFF + 320;
constexpr int LDS_BYTES = 147456;
static_assert(MISC_OFF + 128 <= LDS_BYTES, "LDS map");
#define GAS __attribute__((address_space(1)))
#define LAS __attribute__((address_space(3)))
typedef unsigned short bf16;
typedef unsigned v4u __attribute__((ext_vector_type(4)));
typedef float f32x4 __attribute__((ext_vector_type(4)));
typedef short bf16x8 __attribute__((ext_vector_type(8)));
typedef GAS unsigned gu32;
typedef GAS unsigned long long gu64;
#define RLX_AGENT __ATOMIC_RELAXED, __HIP_MEMORY_SCOPE_AGENT
#define LDS_WAIT() asm volatile("s_waitcnt lgkmcnt(0)" ::: "memory")
#define VM_WAIT() asm volatile("s_waitcnt vmcnt(0)" ::: "memory")
__device__ __forceinline__ unsigned long long rt() { return __builtin_amdgcn_s_memrealtime(); }
__device__ __forceinline__ unsigned f2bf(float f) { unsigned u = __builtin_bit_cast(unsigned, f); return (u + 0x7fffu + ((u >> 16) & 1u)) >> 16; }
__device__ __forceinline__ unsigned pk2(float lo, float hi) { return f2bf(lo) | (f2bf(hi) << 16); }

#define XB_TMO      128
#define XB_XCNT(j)  (256  + 64 * (j))
#define XB_XSUB(j)  (1280 + 64 * (j))
#define XB_XGEN(j)  (2304 + 64 * (j))
#define XB_TOP      3328
#define XB_TOPGEN   3392
#define XCD_BAR_WORDS 3456
#define XB_SPIN_CAP (1u << 18)

__device__ __forceinline__ unsigned xb_ld(unsigned* p)              { return __hip_atomic_load(p, __ATOMIC_RELAXED, __HIP_MEMORY_SCOPE_AGENT); }
__device__ __forceinline__ unsigned xb_add(unsigned* p, unsigned v) { return __hip_atomic_fetch_add(p, v, __ATOMIC_RELAXED, __HIP_MEMORY_SCOPE_AGENT); }
__device__ __forceinline__ unsigned xb_xcc_id() { return (unsigned)__builtin_amdgcn_s_getreg((3 << 11) | 20) & 0xFu; }
#define XB_SPIN(cond, bar) do { unsigned _sp = 0; while (cond) { __builtin_amdgcn_s_sleep(1); \
    if ((++_sp & 255u) == 0u) { if (xb_ld(&(bar)[XB_TMO])) break; if (_sp > XB_SPIN_CAP) { atomicAdd(&(bar)[XB_TMO], 1u); break; } } } } while (0)

struct XcdBarrier {
    unsigned* bar; unsigned x;
    volatile LAS unsigned* st;
};

__device__ __forceinline__ XcdBarrier xcd_barrier_post(unsigned* bar, volatile LAS unsigned* st) {
    XcdBarrier b; b.bar = bar; b.x = xb_xcc_id(); b.st = st;
    if (threadIdx.x == 0) (void)xb_add(&bar[XB_XCNT(b.x)], 1u);
    return b;
}
__device__ __forceinline__ void xcd_barrier_complete(unsigned* bar, unsigned x, unsigned& nloc, unsigned& nx) {
    const unsigned G = gridDim.x * gridDim.y * gridDim.z;
    unsigned sum, cnt, mine, sp = 0u;
    for (;;) {
        sum = 0u; cnt = 0u; mine = 0u;
#pragma unroll
        for (unsigned j = 0; j < 16; ++j) { const unsigned c = xb_ld(&bar[XB_XCNT(j)]); sum += c; cnt += (c > 0u) ? 1u : 0u; mine = (j == x) ? c : mine; }
        if (sum == G) break;
        __builtin_amdgcn_s_sleep(1);
        if ((++sp & 255u) == 0u) { if (xb_ld(&bar[XB_TMO])) break; if (sp > XB_SPIN_CAP) { atomicAdd(&bar[XB_TMO], 1u); break; } }
    }
    nloc = mine > 0u ? mine : 1u; nx = cnt > 0u ? cnt : 1u;
}

__device__ __forceinline__ void xcd_barrier(const XcdBarrier& b) {
    asm volatile("s_waitcnt vmcnt(0)" ::: "memory");
    __syncthreads();
    if (threadIdx.x == 0) {
        unsigned* bar = b.bar;
        __builtin_amdgcn_s_waitcnt(0);
        unsigned nloc = b.st[0], nx = b.st[1];
        if (nloc == 0u) { xcd_barrier_complete(bar, b.x, nloc, nx); b.st[0] = nloc; b.st[1] = nx; }
        const unsigned old = xb_add(&bar[XB_XSUB(b.x)], 1u);
        const unsigned gen = old / nloc;
        if (old + 1u == (gen + 1u) * nloc) {
            __builtin_amdgcn_fence(__ATOMIC_RELEASE, "agent");
            asm volatile("s_waitcnt vmcnt(0)" ::: "memory");
            const unsigned og = xb_add(&bar[XB_TOP], 1u);
            const unsigned tg = og / nx;
            if (og + 1u == (tg + 1u) * nx) xb_add(&bar[XB_TOPGEN], 1u);
            else XB_SPIN(xb_ld(&bar[XB_TOPGEN]) == tg, bar);
            __builtin_amdgcn_fence(__ATOMIC_ACQUIRE, "agent");
            xb_add(&bar[XB_XGEN(b.x)], 1u);
            asm volatile("s_waitcnt vmcnt(0)" ::: "memory");
        } else {
            XB_SPIN(xb_ld(&bar[XB_XGEN(b.x)]) == gen, bar);
            __builtin_amdgcn_fence(__ATOMIC_ACQUIRE, "agent");
            asm volatile("s_waitcnt vmcnt(0)" ::: "memory");
        }
    }
    __syncthreads();
}


namespace epi {
using pg8::f32x4; using pg8::u32x4; using pg8::Unit;
typedef float f32x2_t __attribute__((ext_vector_type(2))); typedef __bf16 bf16x2_t __attribute__((ext_vector_type(2)));
__device__ __forceinline__ unsigned cvt_pk_bf16(float lo, float hi) { f32x2_t v = {lo, hi}; bf16x2_t b = __builtin_convertvector(v, bf16x2_t); return __builtin_bit_cast(unsigned, b); }
typedef GAS unsigned short bf16_t;
typedef GAS float gfloat; typedef GAS f32x4 gf32x4; typedef GAS u32x4 gu32x4;
__device__ __forceinline__ float row_rs(const gfloat* ss, int row) {
    const gf32x4* sp = (const gf32x4*)(ss + (size_t)row * 4);
    const f32x4 a = sp[0], b = sp[M_PAD], c = sp[2 * M_PAD], d = sp[3 * M_PAD];
    const f32x4 t = (a + b) + (c + d);
    const float s = (t[0] + t[1]) + (t[2] + t[3]);
    return __builtin_amdgcn_rsqf(s * (1.0f / 1024.0f) + RMS_EPS);
}
__device__ __forceinline__ float sigmoidf_(float x) { return __builtin_amdgcn_rcpf(1.0f + __builtin_amdgcn_exp2f(-LOG2E * x)); }
__device__ __forceinline__ u32x4 pack8(const f32x4 v0, const f32x4 v1) { u32x4 w; w.x = cvt_pk_bf16(v0[0], v0[1]); w.y = cvt_pk_bf16(v0[2], v0[3]); w.z = cvt_pk_bf16(v1[0], v1[1]); w.w = cvt_pk_bf16(v1[2], v1[3]); return w; }
__device__ __forceinline__ void unpack8(const u32x4 w, f32x4& v0, f32x4& v1) {
    v0[0] = __uint_as_float(w.x << 16); v0[1] = __uint_as_float(w.x & 0xffff0000u); v0[2] = __uint_as_float(w.y << 16); v0[3] = __uint_as_float(w.y & 0xffff0000u);
    v1[0] = __uint_as_float(w.z << 16); v1[1] = __uint_as_float(w.z & 0xffff0000u); v1[2] = __uint_as_float(w.w << 16); v1[3] = __uint_as_float(w.w & 0xffff0000u);
}

struct EpiIn {
    static constexpr bool PERM = true, AFTER_DRAIN = false;
    bf16_t *Q, *UKV, *G; const gfloat* ss; const gfloat* bias;
    __device__ __forceinline__ void operator()(const f32x4 (&acc)[2][2][4][2], const Unit& u, int wr, int wc, int fr, int fq) const {
        int cb = wc * 32 + 8 * fq; asm volatile("" : "+v"(cb), "+v"(fr)); const int pn = u.pn, pm = u.pm;
        if (pn < 2) {
#pragma unroll
            for (int ai = 0; ai < 2; ++ai)
#pragma unroll
                for (int m = 0; m < 4; ++m) { const int row = pm * 256 + ai * 128 + wr * 64 + m * 16 + fr; const float rs = row_rs(ss, row) * QSCALE;
                    bf16_t* rp = Q + (size_t)row * 512 + pn * 256 + cb;
#pragma unroll
                    for (int bj = 0; bj < 2; ++bj) *(gu32x4*)(rp + bj * 128) = pack8(acc[ai][bj][m][0] * rs, acc[ai][bj][m][1] * rs); }
        } else if (pn < 8) {
            bf16_t* base = UKV + (size_t)((pn >> 1) % 3) * (ACT16 / 2); const int c0 = (pn & 1) * 256 + cb;
            if (pm < 64) {
#pragma unroll
                for (int ai = 0; ai < 2; ++ai)
#pragma unroll
                    for (int m = 0; m < 4; ++m) { const int row = pm * 256 + ai * 128 + wr * 64 + m * 16 + fr; const float rs = row_rs(ss, row);
                        const int drow = row + 16 * ((row >> 11) + 1);
                        bf16_t* rp = base + (size_t)drow * 512 + c0;
#pragma unroll
                        for (int bj = 0; bj < 2; ++bj) *(gu32x4*)(rp + bj * 128) = pack8(acc[ai][bj][m][0] * rs, acc[ai][bj][m][1] * rs); }
            } else if (wr == 0) {
                const float rs = row_rs(ss, M_MAIN + fr);
#pragma unroll
                for (int bj = 0; bj < 2; ++bj) { const u32x4 w = pack8(acc[0][bj][0][0] * rs, acc[0][bj][0][1] * rs);
#pragma unroll
                    for (int b2 = 0; b2 < NB; ++b2) *(gu32x4*)(base + (size_t)(b2 * LTOT + fr) * 512 + c0 + bj * 128) = w; }
            }
        } else {
            const int gc = (pn - 8) * 256 + cb;
            f32x4 bv[2][2];
#pragma unroll
            for (int bj = 0; bj < 2; ++bj)
#pragma unroll
                for (int n = 0; n < 2; ++n) bv[bj][n] = *(const gf32x4*)(bias + gc + bj * 128 + 4 * n);
#pragma unroll
            for (int ai = 0; ai < 2; ++ai)
#pragma unroll
                for (int m = 0; m < 4; ++m) { const int row = pm * 256 + ai * 128 + wr * 64 + m * 16 + fr; const float rs = row_rs(ss, row);
                    bf16_t* rp = G + (size_t)row * 2048 + gc;
#pragma unroll
                    for (int bj = 0; bj < 2; ++bj) { f32x4 v0 = acc[ai][bj][m][0] * rs + bv[bj][0], v1 = acc[ai][bj][m][1] * rs + bv[bj][1];
#pragma unroll
                        for (int j = 0; j < 4; ++j) { v0[j] = sigmoidf_(v0[j]); v1[j] = sigmoidf_(v1[j]); }
                        *(gu32x4*)(rp + bj * 128) = pack8(v0, v1); } }
        }
    }
};
struct EpiBrA {
    static constexpr bool PERM = true, AFTER_DRAIN = false;
    const bf16_t* G; bf16_t* MP;
    __device__ __forceinline__ void operator()(const f32x4 (&acc)[2][2][4][2], const Unit& u, int wr, int wc, int fr, int fq) const {
        int cb = wc * 32 + 8 * fq; asm volatile("" : "+v"(cb), "+v"(fr)); cb += u.pn * 256;
#pragma unroll
        for (int ai = 0; ai < 2; ++ai)
#pragma unroll
            for (int m = 0; m < 4; ++m) { const int row = u.pm * 256 + ai * 128 + wr * 64 + m * 16 + fr;
#pragma unroll
                for (int bj = 0; bj < 2; ++bj) { const int col = cb + bj * 128; f32x4 g0, g1; unpack8(*(const gu32x4*)(G + (size_t)row * 2048 + col), g0, g1);
                    *(gu32x4*)(MP + (size_t)row * 1024 + col) = pack8(acc[ai][bj][m][0] * g0, acc[ai][bj][m][1] * g1); } }
    }
};
struct EpiBrB {
    static constexpr bool PERM = true, AFTER_DRAIN = false;
    const bf16_t* G; const bf16_t* MP; bf16_t* MG;
    __device__ __forceinline__ void operator()(const f32x4 (&acc)[2][2][4][2], const Unit& u, int wr, int wc, int fr, int fq) const {
        int cb = wc * 32 + 8 * fq; asm volatile("" : "+v"(cb), "+v"(fr)); cb += u.pn * 256;
#pragma unroll
        for (int ai = 0; ai < 2; ++ai)
#pragma unroll
            for (int m = 0; m < 4; ++m) { const int row = u.pm * 256 + ai * 128 + wr * 64 + m * 16 + fr;
#pragma unroll
                for (int bj = 0; bj < 2; ++bj) { const int col = cb + bj * 128; f32x4 g0, g1, p0, p1;
                    unpack8(*(const gu32x4*)(G + (size_t)row * 2048 + 1024 + col), g0, g1); unpack8(*(const gu32x4*)(MP + (size_t)row * 1024 + col), p0, p1);
                    *(gu32x4*)(MG + (size_t)row * 1024 + col) = pack8(p0 + acc[ai][bj][m][0] * g0, p1 + acc[ai][bj][m][1] * g1); } }
    }
};
struct EpiRes {
    static constexpr bool PERM = true, AFTER_DRAIN = false;
    const gfloat* xin; gfloat* xout; gfloat* xm; bf16_t* XB; gfloat* ssout;
    __device__ __forceinline__ void operator()(const f32x4 (&acc)[2][2][4][2], const Unit& u, int wr, int wc, int fr, int fq) const {
        int cb = wc * 32 + 8 * fq; asm volatile("" : "+v"(cb), "+v"(fr)); cb += u.pn * 256;
#pragma unroll
        for (int ai = 0; ai < 2; ++ai)
#pragma unroll
            for (int m = 0; m < 4; ++m) { const int row = u.pm * 256 + ai * 128 + wr * 64 + m * 16 + fr;
                const gfloat* ip; gfloat* op;
                if (u.pm < 64) { ip = xin + (size_t)row * 1024; op = xout + (size_t)row * 1024; } else { ip = xm + (size_t)(row - M_MAIN) * 1024; op = xm + (size_t)(row - M_MAIN) * 1024; }
                float sq = 0.f;
#pragma unroll
                for (int bj = 0; bj < 2; ++bj) { const int col = cb + bj * 128;
                    const f32x4 v0 = *(const gf32x4*)(ip + col) + acc[ai][bj][m][0], v1 = *(const gf32x4*)(ip + col + 4) + acc[ai][bj][m][1];
                    *(gf32x4*)(op + col) = v0; *(gf32x4*)(op + col + 4) = v1;
                    *(gu32x4*)(XB + (size_t)row * 1024 + col) = pack8(v0, v1);
                    sq += (v0[0] * v0[0] + v0[1] * v0[1]) + (v0[2] * v0[2] + v0[3] * v0[3]) + (v1[0] * v1[0] + v1[1] * v1[1]) + (v1[2] * v1[2] + v1[3] * v1[3]); }
                sq += __shfl_xor(sq, 16); sq += __shfl_xor(sq, 32);
                if (fq == 0) ssout[(size_t)u.pn * (M_PAD * 4) + (size_t)row * 4 + wc] = sq; }
    }
};
struct EpiFfn {
    static constexpr bool PERM = true, AFTER_DRAIN = false;
    const gfloat* ss; bf16_t* HM;
    __device__ __forceinline__ void operator()(const f32x4 (&acc)[2][2][4][2], const Unit& u, int wr, int wc, int fr, int fq) const {
        int cb = wc * 32 + 8 * fq; asm volatile("" : "+v"(cb), "+v"(fr)); cb += u.pn * 128;
#pragma unroll
        for (int ai = 0; ai < 2; ++ai)
#pragma unroll
            for (int m = 0; m < 4; ++m) { const int row = u.pm * 256 + ai * 128 + wr * 64 + m * 16 + fr; const float rs = row_rs(ss, row);
                f32x4 h[2];
#pragma unroll
                for (int n = 0; n < 2; ++n) { const f32x4 g = acc[ai][0][m][n] * rs, up = acc[ai][1][m][n] * rs;
#pragma unroll
                    for (int j = 0; j < 4; ++j) h[n][j] = g[j] * sigmoidf_(g[j]) * up[j]; }
                *(gu32x4*)(HM + (size_t)row * DFF + cb) = pack8(h[0], h[1]); }
    }
};
}

__device__ __forceinline__ float wave_sum(float v) {
#pragma unroll
    for (int o = 1; o < 64; o <<= 1) v += __shfl_xor(v, o);
    return v;
}
__device__ __forceinline__ void p0a_fold(const float* w_in, const float* mix, const float* scale, float* wut, int gtid, int nthr) {
    for (int o = gtid; o < DEPTH * 1024 * 512; o += nthr) {
        const int n = o & 511, k = (o >> 9) & 1023, l = o >> 19, g = n >> 7, d = n & 127;
        const float* wr = w_in + ((size_t)l * 1024 + k) * NIN + 1536 + g * 128;
        const float* mx = mix + ((size_t)(l * 4 + g) * 128) * 128 + d;
        float s = 0.f;
#pragma unroll 8
        for (int c = 0; c < 128; ++c) s += wr[c] * mx[(size_t)c * 128];
        wut[o] = s * scale[l * 512 + n];
    }
}
__device__ __forceinline__ void tr_item(const float* src, int ld, int c0, const float* gk, int k0, bf16* WT, int K, int drow0, LAS float* scr, int lane) {
#pragma unroll 8
    for (int i = 0; i < 32; ++i) { const int kk = 2 * i + (lane >> 5); float v = src[(size_t)(k0 + kk) * ld + c0 + (lane & 31)]; if (gk) v *= gk[k0 + kk]; scr[kk * 33 + (lane & 31)] = v; }
    LDS_WAIT(); asm volatile("" ::: "memory");
    const int c = lane & 7;
#pragma unroll
    for (int j = 0; j < 4; ++j) { const int n = (lane >> 3) + 8 * j; const LAS float* s = scr + (8 * c) * 33 + n;
        v4u o; o.x = pk2(s[0 * 33], s[1 * 33]); o.y = pk2(s[2 * 33], s[3 * 33]); o.z = pk2(s[4 * 33], s[5 * 33]); o.w = pk2(s[6 * 33], s[7 * 33]);
        *(GAS v4u*)(WT + (size_t)(drow0 + n) * K + k0 + 8 * c) = o; }
    LDS_WAIT(); asm volatile("" ::: "memory");
}
struct In14 { const float *x, *meta, *g1, *w_in, *b_gate, *mix, *scale, *wbp, *wbs, *wout, *g2, *wf1, *wf2, *gf; };
__device__ __forceinline__ void p0b_weights(const In14& I, unsigned char* ws, LAS float* scr, int gw, int ngw, int lane) {
    constexpr int I_IN = 16 * 128, I_BP = 8 * 32, I_OUT = 16 * 32, I_F1 = 16 * 176, I_F2 = 44 * 32, I_L = I_IN + 2 * I_BP + I_OUT + I_F1 + I_F2;
    for (int it = gw; it < DEPTH * I_L; it += ngw) {
        const int l = it / I_L; int r = it % I_L;
        if (r < I_IN) { const int kb = r >> 7, nb = r & 127, n0 = nb * 32; const bool fold = (n0 >= 1536 && n0 < 2048);
            const float* src = fold ? (const float*)(ws + WS_WUT) + (size_t)l * 1024 * 512 : I.w_in + (size_t)l * 1024 * NIN;
            tr_item(src, fold ? 512 : NIN, fold ? n0 - 1536 : n0, I.g1 + l * 1024, kb * 64, (bf16*)(ws + WS_WIN) + (size_t)l * NIN * 1024, 1024, n0, scr, lane); continue; }
        r -= I_IN;
        if (r < I_BP) { const int kb = r >> 5, nb = r & 31; tr_item(I.wbp + (size_t)l * 512 * 1024, 1024, nb * 32, nullptr, kb * 64, (bf16*)(ws + WS_WBP) + (size_t)l * 1024 * 512, 512, nb * 32, scr, lane); continue; }
        r -= I_BP;
        if (r < I_BP) { const int kb = r >> 5, nb = r & 31; tr_item(I.wbs + (size_t)l * 512 * 1024, 1024, nb * 32, nullptr, kb * 64, (bf16*)(ws + WS_WBS) + (size_t)l * 1024 * 512, 512, nb * 32, scr, lane); continue; }
        r -= I_BP;
        if (r < I_OUT) { const int kb = r >> 5, nb = r & 31; tr_item(I.wout + (size_t)l * 1024 * 1024, 1024, nb * 32, nullptr, kb * 64, (bf16*)(ws + WS_WOUT) + (size_t)l * 1024 * 1024, 1024, nb * 32, scr, lane); continue; }
        r -= I_OUT;
        if (r < I_F1) { const int kb = r / 176, jb = r % 176, j0 = jb * 32, pn = j0 >> 8, jj = j0 & 255; const int c0 = jj < 128 ? pn * 128 + jj : DFF + pn * 128 + (jj - 128);
            tr_item(I.wf1 + (size_t)l * 1024 * NF1, NF1, c0, I.g2 + l * 1024, kb * 64, (bf16*)(ws + WS_WF1) + (size_t)l * NF1 * 1024, 1024, j0, scr, lane); continue; }
        r -= I_F1;
        { const int kb = r >> 5, nb = r & 31; tr_item(I.wf2 + (size_t)l * DFF * 1024, 1024, nb * 32, nullptr, kb * 64, (bf16*)(ws + WS_WF2) + (size_t)l * 1024 * DFF, DFF, nb * 32, scr, lane); }
    }
}
__device__ __forceinline__ void p0b_rows(const In14& I, unsigned char* ws, int gw, int ngw, int lane) {
    for (int row = gw; row < M_PAD; row += ngw) {
        const float* src = row < M_MAIN ? I.x + (size_t)row * D : (row < M_MAIN + NMETA ? I.meta + (size_t)(row - M_MAIN) * D : nullptr);
        f32x4 v[4]; float s = 0.f;
#pragma unroll
        for (int j = 0; j < 4; ++j) { v[j] = src ? ((const GAS f32x4*)src)[64 * j + lane] : (f32x4){0.f, 0.f, 0.f, 0.f}; s += (v[j].x * v[j].x + v[j].y * v[j].y) + (v[j].z * v[j].z + v[j].w * v[j].w); }
        s = wave_sum(s);
        GAS unsigned long long* o8 = (GAS unsigned long long*)((bf16*)(ws + WS_XB) + (size_t)row * D) + lane;
#pragma unroll
        for (int j = 0; j < 4; ++j) o8[64 * j] = (unsigned long long)pk2(v[j].x, v[j].y) | ((unsigned long long)pk2(v[j].z, v[j].w) << 32);
        if (lane < 16) ((float*)(ws + WS_SSA))[(size_t)(lane >> 2) * (M_PAD * 4) + (size_t)row * 4 + (lane & 3)] = lane == 0 ? s : 0.f;
        if (row >= M_MAIN) { GAS f32x4* xm = (GAS f32x4*)((float*)(ws + WS_XM) + (size_t)(row - M_MAIN) * D);
#pragma unroll
            for (int j = 0; j < 4; ++j) xm[64 * j + lane] = v[j]; }
    }
}
__device__ __forceinline__ float bf_lo(unsigned w) { return __uint_as_float(w << 16); }
__device__ __forceinline__ float bf_hi(unsigned w) { return __uint_as_float(w & 0xffff0000u); }
__device__ __forceinline__ void pool_filter(const bf16* U, bf16* A, int gtid, int nthr) {
    for (int w = gtid; w < (M_MAIN + NMETA) * 64; w += nthr) {
        const int c8 = w & 63, i = w >> 6; int b, p;
        if (i < M_MAIN) { b = i >> 11; p = NMETA + (i & 2047); } else { b = 0; p = i - M_MAIN; }
        const int win = 2 << (c8 >> 4), cnt = (p + 1 < win) ? p + 1 : win;
        const bf16* up = U + (size_t)(b * LTOT + p) * 512 + c8 * 8;
        float a[8], cur[8];
#pragma unroll
        for (int e = 0; e < 8; ++e) a[e] = 0.f;
        for (int j = 0; j < cnt; ++j) { const v4u v = *(const GAS v4u*)(up - (size_t)j * 512);
            const float f[8] = {bf_lo(v.x), bf_hi(v.x), bf_lo(v.y), bf_hi(v.y), bf_lo(v.z), bf_hi(v.z), bf_lo(v.w), bf_hi(v.w)};
#pragma unroll
            for (int e = 0; e < 8; ++e) { a[e] += f[e]; if (j == 0) cur[e] = f[e]; } }
        const float inv = 1.0f / (float)cnt;
        v4u o; o.x = pk2(a[0] * inv - cur[0], a[1] * inv - cur[1]); o.y = pk2(a[2] * inv - cur[2], a[3] * inv - cur[3]);
        o.z = pk2(a[4] * inv - cur[4], a[5] * inv - cur[5]); o.w = pk2(a[6] * inv - cur[6], a[7] * inv - cur[7]);
        *(GAS v4u*)(A + (size_t)i * 512 + c8 * 8) = o;
    }
}
template <bool META_ONLY> __device__ __forceinline__ void attn_simple(const bf16* Q, const bf16* K, const bf16* V, bf16* S, int gw, int ngw, int lane) {
    for (int it = META_ONLY ? NB * NH * (SEQ / 64) + gw : gw; it < NB * NH * (SEQ / 64) + NH; it += ngw) {
        int b, h, p, qrow, smax;
        if (it < NB * NH * (SEQ / 64)) { const int bh = it >> 5, qc = it & 31; b = bh >> 3; h = bh & 7; const int t = qc * 64 + lane; p = NMETA + t; qrow = b * SEQ + t; smax = NMETA + qc * 64 + 63; }
        else { h = it - NB * NH * (SEQ / 64); b = 0; p = lane < NMETA ? lane : 0; qrow = M_MAIN + (lane < NMETA ? lane : 0); smax = NMETA; }
        float q[64], o[64];
        { const GAS v4u* qp = (const GAS v4u*)(Q + (size_t)qrow * 512 + h * 64);
#pragma unroll
          for (int c = 0; c < 8; ++c) { const v4u v = qp[c]; q[8 * c + 0] = bf_lo(v.x); q[8 * c + 1] = bf_hi(v.x); q[8 * c + 2] = bf_lo(v.y); q[8 * c + 3] = bf_hi(v.y); q[8 * c + 4] = bf_lo(v.z); q[8 * c + 5] = bf_hi(v.z); q[8 * c + 6] = bf_lo(v.w); q[8 * c + 7] = bf_hi(v.w); } }
#pragma unroll
        for (int d = 0; d < 64; ++d) o[d] = 0.f;
        float I = 1.0f;
        for (int s = smax - 1; s >= 0; --s) {
#if EARLY_EXIT
            if (!__any(I != 0.0f)) break;
#endif
            int soff = (b * LTOT + s) * 512 + h * 64; asm volatile("" : "+v"(soff));
            const GAS v4u* kp = (const GAS v4u*)(K + soff); const GAS v4u* vp = (const GAS v4u*)(V + soff);
            float z = 0.f;
#pragma unroll
            for (int c = 0; c < 8; ++c) { const v4u v = kp[c];
                z += q[8 * c + 0] * bf_lo(v.x) + q[8 * c + 1] * bf_hi(v.x) + q[8 * c + 2] * bf_lo(v.y) + q[8 * c + 3] * bf_hi(v.y) + q[8 * c + 4] * bf_lo(v.z) + q[8 * c + 5] * bf_hi(v.z) + q[8 * c + 6] * bf_lo(v.w) + q[8 * c + 7] * bf_hi(v.w); }
            float m = __builtin_amdgcn_rcpf(1.0f + __builtin_amdgcn_exp2f(z));
            if (s >= p) m = 1.0f;
            const float In = I * m, w = I - In; I = In;
#pragma unroll
            for (int c = 0; c < 8; ++c) { const v4u v = vp[c];
                o[8 * c + 0] += w * bf_lo(v.x); o[8 * c + 1] += w * bf_hi(v.x); o[8 * c + 2] += w * bf_lo(v.y); o[8 * c + 3] += w * bf_hi(v.y); o[8 * c + 4] += w * bf_lo(v.z); o[8 * c + 5] += w * bf_hi(v.z); o[8 * c + 6] += w * bf_lo(v.w); o[8 * c + 7] += w * bf_hi(v.w); }
        }
        if (it < NB * NH * (SEQ / 64) || lane < NMETA) { GAS v4u* sp = (GAS v4u*)(S + (size_t)qrow * 512 + h * 64);
#pragma unroll
            for (int c = 0; c < 8; ++c) { v4u w; w.x = pk2(o[8 * c + 0], o[8 * c + 1]); w.y = pk2(o[8 * c + 2], o[8 * c + 3]); w.z = pk2(o[8 * c + 4], o[8 * c + 5]); w.w = pk2(o[8 * c + 6], o[8 * c + 7]); sp[c] = w; } }
    }
}
namespace sba {
typedef short bf16x8 __attribute__((ext_vector_type(8)));
typedef float f32x16 __attribute__((ext_vector_type(16)));
typedef short v4i16_t __attribute__((ext_vector_type(4)));
typedef float f32x2_t __attribute__((ext_vector_type(2))); typedef __bf16 bf16x2_t __attribute__((ext_vector_type(2)));
__device__ __forceinline__ unsigned cvtpk(float lo, float hi) { f32x2_t v = {lo, hi}; bf16x2_t b = __builtin_convertvector(v, bf16x2_t); return __builtin_bit_cast(unsigned, b); }
__device__ __forceinline__ int crow(int r, int hi) { return (r & 3) + 8 * (r >> 2) + 4 * hi; }
__device__ __forceinline__ bf16x8 vfrag(LAS const unsigned char* p) {
    const v4i16_t lo = __builtin_amdgcn_ds_read_tr16_b64_v4i16((LAS v4i16_t*)p), hi = __builtin_amdgcn_ds_read_tr16_b64_v4i16((LAS v4i16_t*)(p + 8 * 128));
    return (bf16x8){lo[0], lo[1], lo[2], lo[3], hi[0], hi[1], hi[2], hi[3]};
}
#define SBA_BLOCK(x0, x1, x2, x3, Sv) do { const float P3_ = x3 * (Sv), P2_ = x2 * (Sv), P1_ = x1 * (Sv), P0_ = x0 * (Sv); x3 = (Sv) - P3_; x2 = P3_ - P2_; x1 = P2_ - P1_; x0 = P1_ - P0_; } while (0)
__device__ __forceinline__ void unit(const bf16* Q, const bf16* K, const bf16* V, bf16* S, int b, int h, int qi, LAS unsigned char* vl, int lane) {
    const int ql = lane & 31, hi = lane >> 5;
    const int t0 = 32 * qi, qrow = b * SEQ + t0 + ql, kend = NMETA + t0 + 32;
    bf16x8 qf[4];
    { const GAS bf16x8* qp = (const GAS bf16x8*)(Q + (size_t)qrow * 512 + h * 64 + 8 * hi);
#pragma unroll
      for (int ks = 0; ks < 4; ++ks) qf[ks] = qp[2 * ks]; }
    f32x16 o0, o1;
#pragma unroll
    for (int r = 0; r < 16; ++r) { o0[r] = 0.f; o1[r] = 0.f; }
    float R = 1.0f;
    const bf16* Kb = K + (size_t)b * LTOT * 512 + h * 64; const bf16* Vb = V + (size_t)b * LTOT * 512 + h * 64;
    const int g4 = lane >> 4, i16 = lane & 15;
    LAS const unsigned char* vrd = vl + (4 * hi + (i16 >> 2)) * 128 + (16 * (g4 & 1) + 4 * (i16 & 3)) * 2;
    for (int ts = kend - 64;; ts -= 64) {
        bf16x8 kf[2][4];
#pragma unroll
        for (int blk = 0; blk < 2; ++blk) { int row = ts + 32 * blk + ql; row = row < 0 ? 0 : row;
            const GAS bf16x8* kp = (const GAS bf16x8*)(Kb + (size_t)row * 512 + 8 * hi);
#pragma unroll
            for (int ks = 0; ks < 4; ++ks) kf[blk][ks] = kp[2 * ks]; }
        { int row = ts + lane; row = row < 0 ? 0 : row; const GAS v4u* vp = (const GAS v4u*)(Vb + (size_t)row * 512);
#pragma unroll
          for (int c = 0; c < 8; ++c) { const int ch = (c + lane) & 7; const v4u v = vp[ch]; *(LAS v4u*)(vl + lane * 128 + ch * 16) = v; } }
        f32x16 p0, p1;
#pragma unroll
        for (int r = 0; r < 16; ++r) { p0[r] = 0.f; p1[r] = 0.f; }
#pragma unroll
        for (int ks = 0; ks < 4; ++ks) { p0 = __builtin_amdgcn_mfma_f32_32x32x16_bf16(kf[0][ks], qf[ks], p0, 0, 0, 0); p1 = __builtin_amdgcn_mfma_f32_32x32x16_bf16(kf[1][ks], qf[ks], p1, 0, 0, 0); }
#pragma unroll
        for (int r = 0; r < 16; ++r) { p0[r] = __builtin_amdgcn_rcpf(1.0f + __builtin_amdgcn_exp2f(p0[r])); p1[r] = __builtin_amdgcn_rcpf(1.0f + __builtin_amdgcn_exp2f(p1[r])); }
        if (ts == kend - 64) {
#pragma unroll
            for (int r = 0; r < 16; ++r) if (crow(r, hi) >= ql) p1[r] = 1.0f;
        }
        if (ts < 0) {
#pragma unroll
            for (int r = 0; r < 16; ++r) { if (crow(r, hi) < -ts) p0[r] = 1.0f; if (32 + crow(r, hi) < -ts) p1[r] = 1.0f; }
        }
        float U[8], Pn[8];
#pragma unroll
        for (int g = 0; g < 4; ++g) { p0[4 * g + 2] *= p0[4 * g + 3]; p0[4 * g + 1] *= p0[4 * g + 2]; p0[4 * g] *= p0[4 * g + 1];
                                      p1[4 * g + 2] *= p1[4 * g + 3]; p1[4 * g + 1] *= p1[4 * g + 2]; p1[4 * g] *= p1[4 * g + 1]; }
#pragma unroll
        for (int g = 0; g < 8; ++g) { const float T = g < 4 ? p0[4 * g] : p1[4 * (g - 4)];
            const auto rr = __builtin_amdgcn_permlane32_swap(__float_as_uint(T), __float_as_uint(T), false, false);
            const float a = __uint_as_float(rr[0]), c = __uint_as_float(rr[1]);
            U[g] = a * c;
            Pn[g] = hi ? 1.0f : c;
        }
        float E = R;
#pragma unroll
        for (int g = 7; g >= 0; --g) { const float Sg = E * Pn[g]; E *= U[g];
            if (g < 4) SBA_BLOCK(p0[4 * g], p0[4 * g + 1], p0[4 * g + 2], p0[4 * g + 3], Sg);
            else SBA_BLOCK(p1[4 * (g - 4)], p1[4 * (g - 4) + 1], p1[4 * (g - 4) + 2], p1[4 * (g - 4) + 3], Sg); }
        R = E;
        bf16x8 wf[2][2];
#pragma unroll
        for (int s2 = 0; s2 < 2; ++s2) {
            const v4u a = {cvtpk(p0[8 * s2], p0[8 * s2 + 1]), cvtpk(p0[8 * s2 + 2], p0[8 * s2 + 3]), cvtpk(p0[8 * s2 + 4], p0[8 * s2 + 5]), cvtpk(p0[8 * s2 + 6], p0[8 * s2 + 7])};
            const v4u c = {cvtpk(p1[8 * s2], p1[8 * s2 + 1]), cvtpk(p1[8 * s2 + 2], p1[8 * s2 + 3]), cvtpk(p1[8 * s2 + 4], p1[8 * s2 + 5]), cvtpk(p1[8 * s2 + 6], p1[8 * s2 + 7])};
            wf[0][s2] = __builtin_bit_cast(bf16x8, a); wf[1][s2] = __builtin_bit_cast(bf16x8, c); }
#pragma unroll
        for (int blk = 0; blk < 2; ++blk)
#pragma unroll
            for (int s2 = 0; s2 < 2; ++s2) { LAS const unsigned char* vp = vrd + (32 * blk + 16 * s2) * 128;
                o0 = __builtin_amdgcn_mfma_f32_32x32x16_bf16(vfrag(vp), wf[blk][s2], o0, 0, 0, 0);
                o1 = __builtin_amdgcn_mfma_f32_32x32x16_bf16(vfrag(vp + 64), wf[blk][s2], o1, 0, 0, 0); }
        if (ts <= 0) break;
#if EARLY_EXIT
        if (!__any(R != 0.0f)) break;
#endif
    }
    GAS unsigned long long* sp = (GAS unsigned long long*)(S + (size_t)qrow * 512 + h * 64 + 4 * hi);
#pragma unroll
    for (int g = 0; g < 4; ++g) {
        sp[2 * g] = (unsigned long long)cvtpk(o0[4 * g], o0[4 * g + 1]) | ((unsigned long long)cvtpk(o0[4 * g + 2], o0[4 * g + 3]) << 32);
        sp[8 + 2 * g] = (unsigned long long)cvtpk(o1[4 * g], o1[4 * g + 1]) | ((unsigned long long)cvtpk(o1[4 * g + 2], o1[4 * g + 3]) << 32); }
}
#undef SBA_BLOCK
__device__ __forceinline__ void phase(const bf16* Q, const bf16* K, const bf16* V, bf16* S, LAS unsigned char* lds, int gw, int ngw, int wave, int lane) {
    LAS unsigned char* vl = lds + wave * 8192;
    for (int w = gw; w < NB * NH * 32; w += ngw) { const int bh = w >> 5, j = w & 31;
#pragma unroll 1
        for (int rep = 0; rep < 2; ++rep) unit(Q, K, V, S, bh >> 3, bh & 7, rep ? 63 - j : j, vl, lane); }
}
}
__device__ __forceinline__ void final_norm(float* out, const float* gf, int gw, int ngw, int lane) {
    f32x4 g[4];
#pragma unroll
    for (int j = 0; j < 4; ++j) g[j] = ((const GAS f32x4*)gf)[64 * j + lane];
    for (int row = gw; row < M_MAIN; row += ngw) {
        GAS f32x4* xr = (GAS f32x4*)(out + (size_t)row * D); f32x4 v[4]; float s = 0.f;
#pragma unroll
        for (int j = 0; j < 4; ++j) { v[j] = xr[64 * j + lane]; s += (v[j].x * v[j].x + v[j].y * v[j].y) + (v[j].z * v[j].z + v[j].w * v[j].w); }
        const float rs = 1.0f / sqrtf(wave_sum(s) * (1.0f / D) + RMS_EPS);
#pragma unroll
        for (int j = 0; j < 4; ++j) xr[64 * j + lane] = v[j] * rs * g[j];
    }
}

constexpr int N_PHASES = 15;
struct Args { const float* in[14]; float* out; unsigned char* ws; int ph_lo, ph_hi; };
__global__ void __launch_bounds__(NWAVES * 64, 2) fwd_kernel(Args args) {
    extern __shared__ __attribute__((aligned(16))) unsigned char lds[];
    LAS unsigned char* L = (LAS unsigned char*)lds;
    volatile LAS unsigned* MISC = (volatile LAS unsigned*)(L + MISC_OFF);
    const int G = gridDim.x, bx = blockIdx.x, vcu = (G % 8 == 0) ? (bx % 8) * (G / 8) + bx / 8 : bx;
    const int ngw = G * NWAVES, nthr = G * NWAVES * 64;
#define LANE_VARS int tid = threadIdx.x; asm volatile("" : "+v"(tid)); const int lane = tid & 63, wave = __builtin_amdgcn_readfirstlane(tid >> 6), gw = vcu * NWAVES + wave, gtid = bx * (NWAVES * 64) + tid; (void)lane; (void)gw; (void)gtid;
    unsigned char* ws = args.ws;
    gu32* ctl = (gu32*)(ws + WS_CTL);
    In14 I; I.x = args.in[0]; I.meta = args.in[1]; I.g1 = args.in[2]; I.w_in = args.in[3]; I.b_gate = args.in[4]; I.mix = args.in[5]; I.scale = args.in[6];
    I.wbp = args.in[7]; I.wbs = args.in[8]; I.wout = args.in[9]; I.g2 = args.in[10]; I.wf1 = args.in[11]; I.wf2 = args.in[12]; I.gf = args.in[13];
    float* out = args.out;
    for (int u = threadIdx.x; u < (LDS_BYTES - LDSCTL_OFF) / 4; u += NWAVES * 64) ((LAS unsigned*)(L + LDSCTL_OFF))[u] = 0u;
    __syncthreads();
    const int lo = args.ph_lo, hi = args.ph_hi;
    const bool multi = (hi - lo) > 1;
    XcdBarrier bar; bar.bar = (unsigned*)(ctl + CW_BAR); bar.x = 0; bar.st = nullptr;
    if (multi) bar = xcd_barrier_post((unsigned*)(ctl + CW_BAR), MISC + 8);
#define IN(k) (lo <= (k) && (k) < hi)
#define SEAM(k) do { if (IN(k) && IN((k) + 1)) xcd_barrier(bar); } while (0)
    if (IN(0)) { LANE_VARS p0a_fold(I.w_in, I.mix, I.scale, (float*)(ws + WS_WUT), gtid, nthr); }
    SEAM(0);
    if (IN(1)) { LANE_VARS p0b_weights(I, ws, (LAS float*)(L + RING_OFF + wave * 16384), gw, ngw, lane); p0b_rows(I, ws, gw, ngw, lane); }
    SEAM(1);
    for (int l = 0; l < DEPTH; ++l) {
        const int pb = 2 + 6 * l;
        unsigned char* w = ws; int bxl = bx, Gl = G; asm volatile("" : "+s"(w), "+s"(bxl), "+s"(Gl));
#define WB(off) ((bf16*)(w + (off)))
#define WG(off) ((GAS bf16*)(w + (off)))
#define WF(off) ((GAS float*)(w + (off)))
        if (IN(pb + 0)) {
            pg8::Gemm g{WB(WS_XB), WB(WS_WIN) + (size_t)l * NIN * 1024, M_PAD, NIN, 1024}; pg8::StaticOrder S; S.init(M_PAD, NIN, Gl, bxl);
            epi::EpiIn E{WG(WS_Q), WG(WS_U), WG(WS_G), WF(WS_SSA), (const GAS float*)(I.b_gate + l * 2048)};
            pg8::gemm_phase<epi::EpiIn, pg8::StaticOrder, PG8_ALIGN, PG8_SP2>(L + RING_OFF, g, S, E);
        }
        SEAM(pb + 0);
        if (IN(pb + 1)) { LANE_VARS pool_filter(WB(WS_U), WB(WS_A), gtid, nthr); sba::phase(WB(WS_Q), WB(WS_K), WB(WS_V), WB(WS_S), L + RING_OFF, gw, ngw, wave, lane); attn_simple<true>(WB(WS_Q), WB(WS_K), WB(WS_V), WB(WS_S), gw, ngw, lane); }
        SEAM(pb + 1);
        if (IN(pb + 2)) {
            { pg8::Gemm g{WB(WS_A), WB(WS_WBP) + (size_t)l * 1024 * 512, M_PAD, 1024, 512}; pg8::StaticOrder S; S.init(M_PAD, 1024, Gl, bxl);
              epi::EpiBrA E{WG(WS_G), WG(WS_MP)}; pg8::gemm_phase<epi::EpiBrA, pg8::StaticOrder, PG8_ALIGN, PG8_SP2>(L + RING_OFF, g, S, E); }
            { pg8::Gemm g{WB(WS_S), WB(WS_WBS) + (size_t)l * 1024 * 512, M_PAD, 1024, 512}; pg8::StaticOrder S; S.init(M_PAD, 1024, Gl, bxl);
              epi::EpiBrB E{WG(WS_G), WG(WS_MP), WG(WS_MG)}; pg8::gemm_phase<epi::EpiBrB, pg8::StaticOrder, PG8_ALIGN, PG8_SP2>(L + RING_OFF, g, S, E); }
        }
        SEAM(pb + 2);
        if (IN(pb + 3)) {
            pg8::Gemm g{WB(WS_MG), WB(WS_WOUT) + (size_t)l * 1024 * 1024, M_PAD, 1024, 1024}; pg8::StaticOrder S; S.init(M_PAD, 1024, Gl, bxl);
            epi::EpiRes E{(const GAS float*)(l == 0 ? I.x : out), (GAS float*)out, WF(WS_XM), WG(WS_XB), WF(WS_SSB)};
            pg8::gemm_phase<epi::EpiRes, pg8::StaticOrder, PG8_ALIGN, PG8_SP2>(L + RING_OFF, g, S, E);
        }
        SEAM(pb + 3);
        if (IN(pb + 4)) {
            pg8::Gemm g{WB(WS_XB), WB(WS_WF1) + (size_t)l * NF1 * 1024, M_PAD, NF1, 1024}; pg8::StaticOrder S; S.init(M_PAD, NF1, Gl, bxl);
            epi::EpiFfn E{WF(WS_SSB), WG(WS_HM)};
            pg8::gemm_phase<epi::EpiFfn, pg8::StaticOrder, PG8_ALIGN, PG8_SP2>(L + RING_OFF, g, S, E);
        }
        SEAM(pb + 4);
        if (IN(pb + 5)) {
            pg8::Gemm g{WB(WS_HM), WB(WS_WF2) + (size_t)l * 1024 * DFF, M_PAD, 1024, DFF}; pg8::StaticOrder S; S.init(M_PAD, 1024, Gl, bxl);
            epi::EpiRes E{(const GAS float*)out, (GAS float*)out, WF(WS_XM), WG(WS_XB), WF(WS_SSA)};
            pg8::gemm_phase<epi::EpiRes, pg8::StaticOrder, PG8_ALIGN, PG8_SP2>(L + RING_OFF, g, S, E);
        }
        SEAM(pb + 5);
#undef WB
#undef WG
#undef WF
    }
    if (IN(14)) { LANE_VARS final_norm(out, I.gf, gw, ngw, lane); }
#undef LANE_VARS
#undef IN
#undef SEAM
}

#if defined(DUMP_AFTER)
#ifndef DUMP_LIST
#define DUMP_LIST {WS_G, (size_t)M_PAD * 2048}, {WS_Q, (size_t)M_PAD * 512}, {WS_K, (size_t)NB * LTOT * 512}, {WS_V, (size_t)NB * LTOT * 512}, {WS_U, (size_t)NB * LTOT * 512}
#endif
#ifndef DUMP_F32
#define DUMP_F32 {WS_SSA, (size_t)M_PAD * 16}
#endif
#ifndef DUMP_FSCALE
#define DUMP_FSCALE 0.f
#endif
struct DumpEnt { size_t off, cnt; };
__global__ void dump_kernel(const unsigned char* ws, float* out) {
    const DumpEnt L[] = {DUMP_LIST}; const DumpEnt F[] = {DUMP_F32};
    for (size_t i = (size_t)blockIdx.x * blockDim.x + threadIdx.x; i < (size_t)M_MAIN * D; i += (size_t)gridDim.x * blockDim.x) {
        float v = 0.f;
        for (unsigned j = 0; j < sizeof(L) / sizeof(L[0]); ++j) { const unsigned short h = ((const unsigned short*)(ws + L[j].off))[i % L[j].cnt]; v += __uint_as_float((unsigned)h << 16); }
        for (unsigned j = 0; j < sizeof(F) / sizeof(F[0]); ++j) v += DUMP_FSCALE * ((const float*)(ws + F[j].off))[i % F[j].cnt];
        out[i] = v;
    }
}
#endif
#ifndef MK_LAUNCH_PER_PHASE
#define MK_LAUNCH_PER_PHASE 1
#endif
extern "C" void kernel_launch(void* const* d_in, const int* in_sizes, int n_in, void* d_out, int out_size, void* d_ws, size_t ws_size, hipStream_t stream) {
    static int grid = 0;
    if (grid == 0) {
        if (n_in != 14 || in_sizes[0] != M_MAIN * D || out_size != M_MAIN * D || ws_size < WS_WUT + 4 * MiB) { fprintf(stderr, "kernel_launch: unexpected shapes: n_in %d in0 %d out %d ws %zu (need %zu)\n", n_in, n_in > 0 ? in_sizes[0] : -1, out_size, ws_size, (size_t)WS_END); grid = -1; return; }
        int dev = 0, cus = 0, per_cu = 0;
        if (hipGetDevice(&dev) != hipSuccess || hipDeviceGetAttribute(&cus, hipDeviceAttributeMultiprocessorCount, dev) != hipSuccess) { fprintf(stderr, "kernel_launch: device query failed\n"); grid = -1; return; }
        if (hipFuncSetAttribute((const void*)fwd_kernel, hipFuncAttributeMaxDynamicSharedMemorySize, LDS_BYTES) != hipSuccess) { fprintf(stderr, "kernel_launch: hipFuncSetAttribute failed\n"); grid = -1; return; }
        if (hipOccupancyMaxActiveBlocksPerMultiprocessor(&per_cu, (const void*)fwd_kernel, NWAVES * 64, LDS_BYTES) != hipSuccess || per_cu < 1)
            fprintf(stderr, "kernel_launch: note: occupancy query reports %d workgroups per CU\n", per_cu);
        (void)hipGetLastError();
        grid = cus;
    }
    if (grid < 0) return;
    if (hipMemsetAsync((char*)d_ws + WS_CTL, 0, CTL_ZERO_BYTES, stream) != hipSuccess) { fprintf(stderr, "kernel_launch: memset failed\n"); return; }
    Args a{};
    for (int i = 0; i < 14; ++i) a.in[i] = (const float*)d_in[i];
    a.out = (float*)d_out; a.ws = (unsigned char*)d_ws;
#if defined(DUMP_AFTER)
    for (int p = 0; p <= DUMP_AFTER; ++p) { a.ph_lo = p; a.ph_hi = p + 1; hipLaunchKernelGGL(fwd_kernel, dim3(grid), dim3(NWAVES * 64), LDS_BYTES, stream, a); }
    hipLaunchKernelGGL(dump_kernel, dim3(2048), dim3(256), 0, stream, (const unsigned char*)d_ws, (float*)d_out);
#elif MK_LAUNCH_PER_PHASE
    for (int p = 0; p < N_PHASES; ++p) { a.ph_lo = p; a.ph_hi = p + 1; hipLaunchKernelGGL(fwd_kernel, dim3(grid), dim3(NWAVES * 64), LDS_BYTES, stream, a); }
#else
    a.ph_lo = 0; a.ph_hi = N_PHASES; hipLaunchKernelGGL(fwd_kernel, dim3(grid), dim3(NWAVES * 64), LDS_BYTES, stream, a);
#endif
    const hipError_t le = hipPeekAtLastError();
    if (le != hipSuccess) fprintf(stderr, "kernel_launch: launch failed: %s\n", hipGetErrorName(le));
}
```

```cpp
#define MK_LAUNCH_PER_PHASE 0
#include <hip/hip_runtime.h>
#include <cstdio>
#include <cstdint>
namespace pg8 {
#define PG8_LAS __attribute__((address_space(3)))
typedef unsigned short bf16_t;
typedef short bf16x8 __attribute__((ext_vector_type(8)));
typedef float f32x4 __attribute__((ext_vector_type(4)));
typedef unsigned u32x4 __attribute__((ext_vector_type(4)));
constexpr int BM = 256, BK = 64, HALF = 128, HTB = HALF * BK * 2  , STAGE_BYTES = 8 * HTB, NXCD = 8, WGM = 8;

__host__ __device__ __forceinline__ int lds_byte(int r, int c) { const int st = (r >> 4) * 2 + (c >> 5), rr = r & 15, cc = c & 31, ob = rr * 64 + cc * 2; return st * 1024 + (ob ^ (((ob >> 9) & 1) << 5)); }
__host__ __device__ __forceinline__ void stage_rc(int b, int& R, int& C) { const int st = b / 1024, sb = b % 1024, swz = sb ^ (((sb >> 9) & 1) << 5); R = (st >> 1) * 16 + swz / 64; C = (st & 1) * 32 + (swz % 64) / 2; }
__host__ __device__ __forceinline__ int perm32(int rho) { const int n = rho >> 4, i = rho & 15; return 8 * (i >> 2) + 4 * n + (i & 3); }

struct Unit { int pm, pn; };
struct Gemm { const bf16_t* A; const bf16_t* Bt; int M, N, K; };

struct StaticOrder {
    int nM, nN, nwg, G, c;
    __host__ __device__ void init(int M, int N, int G_, int c_) { nM = M / BM; nN = N / BM; nwg = nM * nN; G = G_; c = c_; }
    __host__ __device__ bool next(int i, Unit& u) const {
        const long L = (long)i * G + c; if (L >= nwg) return false;
        int wgid = (int)L; { const int q = nwg / NXCD, r = nwg % NXCD, xcd = wgid % NXCD, off = wgid / NXCD; wgid = (xcd < r ? xcd * (q + 1) : r * (q + 1) + (xcd - r) * q) + off; }
        const int nig = WGM * nN, gid = wgid / nig, fm = gid * WGM, gsz = (nM - fm) < WGM ? (nM - fm) : WGM;
        u.pm = fm + ((wgid % nig) % gsz); u.pn = (wgid % nig) / gsz; return true;
    }
    __device__ __forceinline__ void a_ready(const Unit&) const {}
    __device__ __forceinline__ void done(const Unit&) const {}
};

__device__ __forceinline__ unsigned cvt_pk_bf16(float lo, float hi) { unsigned r; asm volatile("v_cvt_pk_bf16_f32 %0, %1, %2" : "=v"(r) : "v"(lo), "v"(hi)); return r; }
template <class Epi, class Sched, bool ALIGN_EPI = false, bool SP2 = false>
__device__ __forceinline__ void gemm_phase(PG8_LAS unsigned char* lds, const Gemm g, const Sched& S, const Epi& E) {
    int tid = threadIdx.x; asm volatile("" : "+v"(tid));
    const int wid = __builtin_amdgcn_readfirstlane(tid >> 6), lane = tid & 63, wr = wid >> 2, wc = wid & 3, fr = lane & 15, fq = lane >> 4;
    const int K = g.K, nt = K / BK;
    unsigned voffA[2], voffB[2];
#pragma unroll
    for (int i = 0; i < 2; ++i) { int R, C; stage_rc(tid * 16 + i * 8192, R, C); const int Rb = Epi::PERM ? ((R & ~31) + perm32(R & 31)) : R;
        voffA[i] = (unsigned)(R * K + C) * 2u; voffB[i] = (unsigned)(Rb * K + C) * 2u; }
    const size_t kstep = (size_t)(BK * 2);
    const size_t hstep = (size_t)HALF * K * 2;
    const size_t tstep = 2 * hstep;
    const unsigned ldsw = (unsigned)wid * 1024u;
    const int aoff = lds_byte(wr * 64 + fr, fq * 8), boff = lds_byte(wc * 32 + fr, fq * 8);
#define PG8_SA(b, h) (((b) * 2 + (h)) * HTB)
#define PG8_SB(b, h) ((4 + (b) * 2 + (h)) * HTB)
#define PG8_STAGE(bufoff, gbase, voff) do { _Pragma("unroll") for (int _i = 0; _i < 2; ++_i) \
        __builtin_amdgcn_global_load_lds((const unsigned*)((const char*)(gbase) + (voff)[_i]), (PG8_LAS unsigned*)(lds + (bufoff) + ldsw + _i * 8192), 16, 0, 0); } while (0)
#define PG8_LDA(dst, b, h) do { _Pragma("unroll") for (int m = 0; m < 4; ++m) _Pragma("unroll") for (int k = 0; k < 2; ++k) dst[m][k] = *(const PG8_LAS bf16x8*)(lds + PG8_SA(b, h) + aoff + m * 2048 + k * 1024); } while (0)
#define PG8_LDB(dst, b, h) do { _Pragma("unroll") for (int n = 0; n < 2; ++n) _Pragma("unroll") for (int k = 0; k < 2; ++k) dst[n][k] = *(const PG8_LAS bf16x8*)(lds + PG8_SB(b, h) + boff + n * 2048 + k * 1024); } while (0)
#define PG8_MMA(ai, bj, At, Bt) do { __builtin_amdgcn_s_setprio(1); _Pragma("unroll") for (int m = 0; m < 4; ++m) _Pragma("unroll") for (int n = 0; n < 2; ++n) _Pragma("unroll") for (int k = 0; k < 2; ++k) \
        acc[ai][bj][m][n] = __builtin_amdgcn_mfma_f32_16x16x32_bf16(Bt[n][k], At[m][k], acc[ai][bj][m][n], 0, 0, 0); __builtin_amdgcn_s_setprio(0); } while (0)
#define PG8_WAIT_V(n) asm volatile("s_waitcnt vmcnt(" #n ")" ::: "memory")
#define PG8_WAIT_L(n) asm volatile("s_waitcnt lgkmcnt(" #n ")" ::: "memory")
#define PG8_BAR __builtin_amdgcn_s_barrier()
#define PG8_SCHED __builtin_amdgcn_sched_barrier(0)
    Unit cur, nxt; int ui = 0;
    if (!S.next(0, cur)) return;
    f32x4 acc[2][2][4][2];
#pragma unroll
    for (int a = 0; a < 2; ++a)
#pragma unroll
        for (int b = 0; b < 2; ++b)
#pragma unroll
            for (int m = 0; m < 4; ++m)
#pragma unroll
                for (int n = 0; n < 2; ++n) acc[a][b][m][n] = (f32x4){0.f, 0.f, 0.f, 0.f};
    bf16x8 At[4][2], B0[2][2], B1[2][2];
    const char* cA = (const char*)g.A + (size_t)cur.pm * tstep; const char* cB = (const char*)g.Bt + (size_t)cur.pn * tstep;
    S.a_ready(cur);
    if constexpr (SP2) {
        PG8_STAGE(PG8_SB(0, 0), cB, voffB); PG8_STAGE(PG8_SB(0, 1), cB + hstep, voffB); PG8_STAGE(PG8_SA(0, 0), cA, voffA); PG8_STAGE(PG8_SA(0, 1), cA + hstep, voffA);
        if (wr == 1) PG8_BAR;
        PG8_WAIT_V(2); PG8_BAR;
        PG8_STAGE(PG8_SB(1, 0), cB + kstep, voffB); PG8_STAGE(PG8_SA(1, 0), cA + kstep, voffA); PG8_STAGE(PG8_SB(1, 1), cB + hstep + kstep, voffB);
        PG8_WAIT_V(6); PG8_BAR;
    } else {
        PG8_STAGE(PG8_SB(0, 0), cB, voffB); PG8_STAGE(PG8_SA(0, 0), cA, voffA); PG8_STAGE(PG8_SB(0, 1), cB + hstep, voffB); PG8_STAGE(PG8_SA(0, 1), cA + hstep, voffA);
        if (wr == 1) PG8_BAR;
        PG8_WAIT_V(4); PG8_BAR;
        PG8_STAGE(PG8_SB(1, 0), cB + kstep, voffB); PG8_STAGE(PG8_SA(1, 0), cA + kstep, voffA); PG8_STAGE(PG8_SB(1, 1), cB + hstep + kstep, voffB);
        PG8_WAIT_V(6); PG8_BAR;
    }
    for (;;) {
        const bool has_next = S.next(ui + 1, nxt);
        const char* nA = has_next ? (const char*)g.A + (size_t)nxt.pm * tstep : cA; const char* nB = has_next ? (const char*)g.Bt + (size_t)nxt.pn * tstep : cB;
        for (int t = 0; t < nt; t += 2) {
            const bool last = (t == nt - 2);
            const char* a1 = cA + (size_t)(t + 1) * kstep;
            const char* a2 = last ? nA : cA + (size_t)(t + 2) * kstep; const char* b2 = last ? nB : cB + (size_t)(t + 2) * kstep;
            const char* a3 = a2 + kstep; const char* b3 = b2 + kstep;
            if (last && has_next) S.a_ready(nxt);
            if constexpr (SP2) {
            PG8_LDB(B0, 0, 0); PG8_LDB(B1, 0, 1); PG8_SCHED; PG8_LDA(At, 0, 0); PG8_STAGE(PG8_SA(1, 1), a1 + hstep, voffA);
            PG8_WAIT_V(8); PG8_WAIT_L(0); PG8_BAR; PG8_MMA(0, 0, At, B0); PG8_MMA(0, 1, At, B1); PG8_BAR; PG8_SCHED;
            PG8_LDA(At, 0, 1); PG8_STAGE(PG8_SB(0, 0), b2, voffB); PG8_STAGE(PG8_SB(0, 1), b2 + hstep, voffB); PG8_STAGE(PG8_SA(0, 0), a2, voffA);
            PG8_WAIT_V(8); PG8_WAIT_L(0); PG8_BAR; PG8_MMA(1, 0, At, B0); PG8_MMA(1, 1, At, B1); PG8_BAR; PG8_SCHED;
            PG8_LDB(B0, 1, 0); PG8_LDB(B1, 1, 1); PG8_SCHED; PG8_LDA(At, 1, 0); PG8_STAGE(PG8_SA(0, 1), a2 + hstep, voffA);
            PG8_WAIT_V(8); PG8_WAIT_L(0); PG8_BAR; PG8_MMA(0, 0, At, B0); PG8_MMA(0, 1, At, B1); PG8_BAR; PG8_SCHED;
            PG8_LDA(At, 1, 1); PG8_STAGE(PG8_SB(1, 0), b3, voffB); PG8_STAGE(PG8_SB(1, 1), b3 + hstep, voffB); PG8_STAGE(PG8_SA(1, 0), a3, voffA);
            PG8_WAIT_V(8); PG8_WAIT_L(0); PG8_BAR; PG8_MMA(1, 0, At, B0); PG8_MMA(1, 1, At, B1); PG8_BAR; PG8_SCHED;
            } else {
            PG8_LDB(B0, 0, 0); PG8_SCHED; PG8_LDA(At, 0, 0); PG8_STAGE(PG8_SA(1, 1), a1 + hstep, voffA);
            PG8_WAIT_L(8); PG8_BAR; PG8_WAIT_L(0); PG8_MMA(0, 0, At, B0); PG8_BAR; PG8_SCHED;
            PG8_LDB(B1, 0, 1); PG8_STAGE(PG8_SB(0, 0), b2, voffB);
            PG8_BAR; PG8_WAIT_L(0); PG8_MMA(0, 1, At, B1); PG8_BAR;
            PG8_LDA(At, 0, 1); PG8_STAGE(PG8_SA(0, 0), a2, voffA);
            PG8_BAR; PG8_WAIT_L(0); PG8_MMA(1, 0, At, B0); PG8_BAR; PG8_SCHED;
            PG8_STAGE(PG8_SB(0, 1), b2 + hstep, voffB);
            PG8_WAIT_V(6); PG8_BAR; PG8_MMA(1, 1, At, B1); PG8_BAR;
            PG8_LDB(B0, 1, 0); PG8_SCHED; PG8_LDA(At, 1, 0); PG8_STAGE(PG8_SA(0, 1), a2 + hstep, voffA);
            PG8_WAIT_L(8); PG8_BAR; PG8_WAIT_L(0); PG8_MMA(0, 0, At, B0); PG8_BAR; PG8_SCHED;
            PG8_LDB(B1, 1, 1); PG8_STAGE(PG8_SB(1, 0), b3, voffB);
            PG8_BAR; PG8_WAIT_L(0); PG8_MMA(0, 1, At, B1); PG8_BAR;
            PG8_LDA(At, 1, 1); PG8_STAGE(PG8_SA(1, 0), a3, voffA);
            PG8_BAR; PG8_WAIT_L(0); PG8_MMA(1, 0, At, B0); PG8_BAR; PG8_SCHED;
            PG8_STAGE(PG8_SB(1, 1), b3 + hstep, voffB);
            PG8_WAIT_V(6); PG8_BAR; PG8_MMA(1, 1, At, B1); PG8_BAR;
            }
        }
        if constexpr (ALIGN_EPI) { if (wr == 0) PG8_BAR; }
        if constexpr (!Epi::AFTER_DRAIN) { E(acc, cur, wr, wc, fr, fq); S.done(cur); }
        if (!has_next) break;
#pragma unroll
        for (int a = 0; a < 2; ++a)
#pragma unroll
            for (int b = 0; b < 2; ++b)
#pragma unroll
                for (int m = 0; m < 4; ++m)
#pragma unroll
                    for (int n = 0; n < 2; ++n) acc[a][b][m][n] = (f32x4){0.f, 0.f, 0.f, 0.f};
        cur = nxt; cA = nA; cB = nB; ++ui;
        if constexpr (ALIGN_EPI) { if (wr == 1) PG8_BAR; }
    }
    PG8_WAIT_V(0);
    if constexpr (!ALIGN_EPI) { if (wr == 0) PG8_BAR; }
    PG8_BAR;
    if constexpr (Epi::AFTER_DRAIN) { E.fused(acc, cur, wr, wc, fr, fq, lds, wid, lane); S.done(cur); }
#undef PG8_SA
#undef PG8_SB
#undef PG8_STAGE
#undef PG8_LDA
#undef PG8_LDB
#undef PG8_MMA
#undef PG8_WAIT_V
#undef PG8_WAIT_L
#undef PG8_BAR
#undef PG8_SCHED
}
}

#ifndef PG8_SP2
#define PG8_SP2 true
#endif
#ifndef PG8_ALIGN
#define PG8_ALIGN true
#endif

constexpr int NWAVES = 8;
constexpr int D = 1024, NB = 8, SEQ = 2048, NMETA = 16, LTOT = SEQ + NMETA, DEPTH = 2;
constexpr int M_MAIN = NB * SEQ;
constexpr int M_PAD = M_MAIN + 256;
constexpr int NIN = 4096, NH = 8, HD = 64, DFF = 2816, NF1 = 2 * DFF;
constexpr float RMS_EPS = 1e-6f;
constexpr float LOG2E = 1.4426950408889634f;
constexpr float QSCALE = 0.125f * LOG2E;
#ifndef EARLY_EXIT
#define EARLY_EXIT 1
#endif

constexpr size_t MiB = 1u << 20;
constexpr size_t WS_CTL = 0, CTL_ZERO_BYTES = 1 * MiB;
constexpr size_t WS_WIN = 1 * MiB;
constexpr size_t WS_WBP = 17 * MiB;
constexpr size_t WS_WBS = 19 * MiB;
constexpr size_t WS_WOUT = 21 * MiB;
constexpr size_t WS_WF1 = 25 * MiB;
constexpr size_t WS_WF2 = 47 * MiB;
constexpr size_t WS_SSA = 58 * MiB;
constexpr size_t WS_SSB = WS_SSA + 1280 * 1024;
constexpr size_t WS_XM = WS_SSB + 1280 * 1024;
constexpr size_t WS_XB = 62 * MiB;
constexpr size_t ACT16 = (size_t)M_PAD * 512 * 2;
constexpr size_t WS_A = WS_XB, WS_S = WS_XB + ACT16;
constexpr size_t WS_Q = WS_XB + 2 * ACT16;
constexpr size_t WS_U = WS_Q + ACT16, WS_K = WS_U + ACT16, WS_V = WS_K + ACT16, WS_G = WS_V + ACT16;
static_assert(WS_K == WS_U + ACT16 && WS_V == WS_U + 2 * ACT16, "EpiIn addresses K and V relative to U");
constexpr size_t WS_MP = WS_Q, WS_MG = WS_K, WS_HM = WS_Q;
constexpr size_t WS_END = WS_G + 4 * ACT16;
constexpr size_t WS_WUT = WS_END;
static_assert(WS_XM + 1 * MiB <= WS_XB && WS_WF2 + 11 * MiB <= WS_SSA && WS_WUT + 4 * MiB <= 256 * MiB, "d_ws map");
static_assert(WS_HM + (size_t)M_PAD * DFF * 2 <= WS_END, "HM overlay");
constexpr int CW_TMO = 0, CW_CODE = 1;
constexpr int CW_BAR = 4096;

constexpr int RING_OFF = 0, RING_BYTES = 131072;
constexpr int LDSCTL_OFF = RING_BYTES, MISC_OFF = LDSCTL_OFF + 320;
constexpr int LDS_BYTES = 147456;
static_assert(MISC_OFF + 128 <= LDS_BYTES, "LDS map");
#define GAS __attribute__((address_space(1)))
#define LAS __attribute__((address_space(3)))
typedef unsigned short bf16;
typedef unsigned v4u __attribute__((ext_vector_type(4)));
typedef float f32x4 __attribute__((ext_vector_type(4)));
typedef short bf16x8 __attribute__((ext_vector_type(8)));
typedef GAS unsigned gu32;
typedef GAS unsigned long long gu64;
#define RLX_AGENT __ATOMIC_RELAXED, __HIP_MEMORY_SCOPE_AGENT
#define LDS_WAIT() asm volatile("s_waitcnt lgkmcnt(0)" ::: "memory")
#define VM_WAIT() asm volatile("s_waitcnt vmcnt(0)" ::: "memory")
__device__ __forceinline__ unsigned long long rt() { return __builtin_amdgcn_s_memrealtime(); }
__device__ __forceinline__ unsigned f2bf(float f) { unsigned u = __builtin_bit_cast(unsigned, f); return (u + 0x7fffu + ((u >> 16) & 1u)) >> 16; }
__device__ __forceinline__ unsigned pk2(float lo, float hi) { return f2bf(lo) | (f2bf(hi) << 16); }

#define XB_TMO      128
#define XB_XCNT(j)  (256  + 64 * (j))
#define XB_XSUB(j)  (1280 + 64 * (j))
#define XB_XGEN(j)  (2304 + 64 * (j))
#define XB_TOP      3328
#define XB_TOPGEN   3392
#define XCD_BAR_WORDS 3456
#define XB_SPIN_CAP (1u << 18)

__device__ __forceinline__ unsigned xb_ld(unsigned* p)              { return __hip_atomic_load(p, __ATOMIC_RELAXED, __HIP_MEMORY_SCOPE_AGENT); }
__device__ __forceinline__ unsigned xb_add(unsigned* p, unsigned v) { return __hip_atomic_fetch_add(p, v, __ATOMIC_RELAXED, __HIP_MEMORY_SCOPE_AGENT); }
__device__ __forceinline__ unsigned xb_xcc_id() { return (unsigned)__builtin_amdgcn_s_getreg((3 << 11) | 20) & 0xFu; }
#define XB_SPIN(cond, bar) do { unsigned _sp = 0; while (cond) { __builtin_amdgcn_s_sleep(1); \
    if ((++_sp & 255u) == 0u) { if (xb_ld(&(bar)[XB_TMO])) break; if (_sp > XB_SPIN_CAP) { atomicAdd(&(bar)[XB_TMO], 1u); break; } } } } while (0)

struct XcdBarrier {
    unsigned* bar; unsigned x;
    volatile LAS unsigned* st;
};

__device__ __forceinline__ XcdBarrier xcd_barrier_post(unsigned* bar, volatile LAS unsigned* st) {
    XcdBarrier b; b.bar = bar; b.x = xb_xcc_id(); b.st = st;
    if (threadIdx.x == 0) (void)xb_add(&bar[XB_XCNT(b.x)], 1u);
    return b;
}
__device__ __forceinline__ void xcd_barrier_complete(unsigned* bar, unsigned x, unsigned& nloc, unsigned& nx) {
    const unsigned G = gridDim.x * gridDim.y * gridDim.z;
    unsigned sum, cnt, mine, sp = 0u;
    for (;;) {
        sum = 0u; cnt = 0u; mine = 0u;
#pragma unroll
        for (unsigned j = 0; j < 16; ++j) { const unsigned c = xb_ld(&bar[XB_XCNT(j)]); sum += c; cnt += (c > 0u) ? 1u : 0u; mine = (j == x) ? c : mine; }
        if (sum == G) break;
        __builtin_amdgcn_s_sleep(1);
        if ((++sp & 255u) == 0u) { if (xb_ld(&bar[XB_TMO])) break; if (sp > XB_SPIN_CAP) { atomicAdd(&bar[XB_TMO], 1u); break; } }
    }
    nloc = mine > 0u ? mine : 1u; nx = cnt > 0u ? cnt : 1u;
}

__device__ __forceinline__ void xcd_barrier(const XcdBarrier& b) {
    asm volatile("s_waitcnt vmcnt(0)" ::: "memory");
    __syncthreads();
    if (threadIdx.x == 0) {
        unsigned* bar = b.bar;
        __builtin_amdgcn_s_waitcnt(0);
        unsigned nloc = b.st[0], nx = b.st[1];
        if (nloc == 0u) { xcd_barrier_complete(bar, b.x, nloc, nx); b.st[0] = nloc; b.st[1] = nx; }
        const unsigned old = xb_add(&bar[XB_XSUB(b.x)], 1u);
        const unsigned gen = old / nloc;
        if (old + 1u == (gen + 1u) * nloc) {
            __builtin_amdgcn_fence(__ATOMIC_RELEASE, "agent");
            asm volatile("s_waitcnt vmcnt(0)" ::: "memory");
            const unsigned og = xb_add(&bar[XB_TOP], 1u);
            const unsigned tg = og / nx;
            if (og + 1u == (tg + 1u) * nx) xb_add(&bar[XB_TOPGEN], 1u);
            else XB_SPIN(xb_ld(&bar[XB_TOPGEN]) == tg, bar);
            __builtin_amdgcn_fence(__ATOMIC_ACQUIRE, "agent");
            xb_add(&bar[XB_XGEN(b.x)], 1u);
            asm volatile("s_waitcnt vmcnt(0)" ::: "memory");
        } else {
            XB_SPIN(xb_ld(&bar[XB_XGEN(b.x)]) == gen, bar);
            __builtin_amdgcn_fence(__ATOMIC_ACQUIRE, "agent");
            asm volatile("s_waitcnt vmcnt(0)" ::: "memory");
        }
    }
    __syncthreads();
}


namespace epi {
using pg8::f32x4; using pg8::u32x4; using pg8::Unit;
typedef float f32x2_t __attribute__((ext_vector_type(2))); typedef __bf16 bf16x2_t __attribute__((ext_vector_type(2)));
__device__ __forceinline__ unsigned cvt_pk_bf16(float lo, float hi) { f32x2_t v = {lo, hi}; bf16x2_t b = __builtin_convertvector(v, bf16x2_t); return __builtin_bit_cast(unsigned, b); }
typedef GAS unsigned short bf16_t;
typedef GAS float gfloat; typedef GAS f32x4 gf32x4; typedef GAS u32x4 gu32x4;
__device__ __forceinline__ float row_rs(const gfloat* ss, int row) {
    const gf32x4* sp = (const gf32x4*)(ss + (size_t)row * 4);
    const f32x4 a = sp[0], b = sp[M_PAD], c = sp[2 * M_PAD], d = sp[3 * M_PAD];
    const f32x4 t = (a + b) + (c + d);
    const float s = (t[0] + t[1]) + (t[2] + t[3]);
    return __builtin_amdgcn_rsqf(s * (1.0f / 1024.0f) + RMS_EPS);
}
__device__ __forceinline__ float sigmoidf_(float x) { return __builtin_amdgcn_rcpf(1.0f + __builtin_amdgcn_exp2f(-LOG2E * x)); }
__device__ __forceinline__ u32x4 pack8(const f32x4 v0, const f32x4 v1) { u32x4 w; w.x = cvt_pk_bf16(v0[0], v0[1]); w.y = cvt_pk_bf16(v0[2], v0[3]); w.z = cvt_pk_bf16(v1[0], v1[1]); w.w = cvt_pk_bf16(v1[2], v1[3]); return w; }
__device__ __forceinline__ void unpack8(const u32x4 w, f32x4& v0, f32x4& v1) {
    v0[0] = __uint_as_float(w.x << 16); v0[1] = __uint_as_float(w.x & 0xffff0000u); v0[2] = __uint_as_float(w.y << 16); v0[3] = __uint_as_float(w.y & 0xffff0000u);
    v1[0] = __uint_as_float(w.z << 16); v1[1] = __uint_as_float(w.z & 0xffff0000u); v1[2] = __uint_as_float(w.w << 16); v1[3] = __uint_as_float(w.w & 0xffff0000u);
}

struct EpiIn {
    static constexpr bool PERM = true, AFTER_DRAIN = false;
    bf16_t *Q, *UKV, *G; const gfloat* ss; const gfloat* bias;
    __device__ __forceinline__ void operator()(const f32x4 (&acc)[2][2][4][2], const Unit& u, int wr, int wc, int fr, int fq) const {
        int cb = wc * 32 + 8 * fq; asm volatile("" : "+v"(cb), "+v"(fr)); const int pn = u.pn, pm = u.pm;
        if (pn < 2) {
#pragma unroll
            for (int ai = 0; ai < 2; ++ai)
#pragma unroll
                for (int m = 0; m < 4; ++m) { const int row = pm * 256 + ai * 128 + wr * 64 + m * 16 + fr; const float rs = row_rs(ss, row) * QSCALE;
                    bf16_t* rp = Q + (size_t)row * 512 + pn * 256 + cb;
#pragma unroll
                    for (int bj = 0; bj < 2; ++bj) *(gu32x4*)(rp + bj * 128) = pack8(acc[ai][bj][m][0] * rs, acc[ai][bj][m][1] * rs); }
        } else if (pn < 8) {
            bf16_t* base = UKV + (size_t)((pn >> 1) % 3) * (ACT16 / 2); const int c0 = (pn & 1) * 256 + cb;
            if (pm < 64) {
#pragma unroll
                for (int ai = 0; ai < 2; ++ai)
#pragma unroll
                    for (int m = 0; m < 4; ++m) { const int row = pm * 256 + ai * 128 + wr * 64 + m * 16 + fr; const float rs = row_rs(ss, row);
                        const int drow = row + 16 * ((row >> 11) + 1);
                        bf16_t* rp = base + (size_t)drow * 512 + c0;
#pragma unroll
                        for (int bj = 0; bj < 2; ++bj) *(gu32x4*)(rp + bj * 128) = pack8(acc[ai][bj][m][0] * rs, acc[ai][bj][m][1] * rs); }
            } else if (wr == 0) {
                const float rs = row_rs(ss, M_MAIN + fr);
#pragma unroll
                for (int bj = 0; bj < 2; ++bj) { const u32x4 w = pack8(acc[0][bj][0][0] * rs, acc[0][bj][0][1] * rs);
#pragma unroll
                    for (int b2 = 0; b2 < NB; ++b2) *(gu32x4*)(base + (size_t)(b2 * LTOT + fr) * 512 + c0 + bj * 128) = w; }
            }
        } else {
            const int gc = (pn - 8) * 256 + cb;
            f32x4 bv[2][2];
#pragma unroll
            for (int bj = 0; bj < 2; ++bj)
#pragma unroll
                for (int n = 0; n < 2; ++n) bv[bj][n] = *(const gf32x4*)(bias + gc + bj * 128 + 4 * n);
#pragma unroll
            for (int ai = 0; ai < 2; ++ai)
#pragma unroll
                for (int m = 0; m < 4; ++m) { const int row = pm * 256 + ai * 128 + wr * 64 + m * 16 + fr; const float rs = row_rs(ss, row);
                    bf16_t* rp = G + (size_t)row * 2048 + gc;
#pragma unroll
                    for (int bj = 0; bj < 2; ++bj) { f32x4 v0 = acc[ai][bj][m][0] * rs + bv[bj][0], v1 = acc[ai][bj][m][1] * rs + bv[bj][1];
#pragma unroll
                        for (int j = 0; j < 4; ++j) { v0[j] = sigmoidf_(v0[j]); v1[j] = sigmoidf_(v1[j]); }
                        *(gu32x4*)(rp + bj * 128) = pack8(v0, v1); } }
        }
    }
};
struct EpiBrA {
    static constexpr bool PERM = true, AFTER_DRAIN = false;
    const bf16_t* G; bf16_t* MP;
    __device__ __forceinline__ void operator()(const f32x4 (&acc)[2][2][4][2], const Unit& u, int wr, int wc, int fr, int fq) const {
        int cb = wc * 32 + 8 * fq; asm volatile("" : "+v"(cb), "+v"(fr)); cb += u.pn * 256;
#pragma unroll
        for (int ai = 0; ai < 2; ++ai)
#pragma unroll
            for (int m = 0; m < 4; ++m) { const int row = u.pm * 256 + ai * 128 + wr * 64 + m * 16 + fr;
#pragma unroll
                for (int bj = 0; bj < 2; ++bj) { const int col = cb + bj * 128; f32x4 g0, g1; unpack8(*(const gu32x4*)(G + (size_t)row * 2048 + col), g0, g1);
                    *(gu32x4*)(MP + (size_t)row * 1024 + col) = pack8(acc[ai][bj][m][0] * g0, acc[ai][bj][m][1] * g1); } }
    }
};
struct EpiBrB {
    static constexpr bool PERM = true, AFTER_DRAIN = false;
    const bf16_t* G; const bf16_t* MP; bf16_t* MG;
    __device__ __forceinline__ void operator()(const f32x4 (&acc)[2][2][4][2], const Unit& u, int wr, int wc, int fr, int fq) const {
        int cb = wc * 32 + 8 * fq; asm volatile("" : "+v"(cb), "+v"(fr)); cb += u.pn * 256;
#pragma unroll
        for (int ai = 0; ai < 2; ++ai)
#pragma unroll
            for (int m = 0; m < 4; ++m) { const int row = u.pm * 256 + ai * 128 + wr * 64 + m * 16 + fr;
#pragma unroll
                for (int bj = 0; bj < 2; ++bj) { const int col = cb + bj * 128; f32x4 g0, g1, p0, p1;
                    unpack8(*(const gu32x4*)(G + (size_t)row * 2048 + 1024 + col), g0, g1); unpack8(*(const gu32x4*)(MP + (size_t)row * 1024 + col), p0, p1);
                    *(gu32x4*)(MG + (size_t)row * 1024 + col) = pack8(p0 + acc[ai][bj][m][0] * g0, p1 + acc[ai][bj][m][1] * g1); } }
    }
};
struct EpiRes {
    static constexpr bool PERM = true, AFTER_DRAIN = false;
    const gfloat* xin; gfloat* xout; gfloat* xm; bf16_t* XB; gfloat* ssout;
    __device__ __forceinline__ void operator()(const f32x4 (&acc)[2][2][4][2], const Unit& u, int wr, int wc, int fr, int fq) const {
        int cb = wc * 32 + 8 * fq; asm volatile("" : "+v"(cb), "+v"(fr)); cb += u.pn * 256;
#pragma unroll
        for (int ai = 0; ai < 2; ++ai)
#pragma unroll
            for (int m = 0; m < 4; ++m) { const int row = u.pm * 256 + ai * 128 + wr * 64 + m * 16 + fr;
                const gfloat* ip; gfloat* op;
                if (u.pm < 64) { ip = xin + (size_t)row * 1024; op = xout + (size_t)row * 1024; } else { ip = xm + (size_t)(row - M_MAIN) * 1024; op = xm + (size_t)(row - M_MAIN) * 1024; }
                float sq = 0.f;
#pragma unroll
                for (int bj = 0; bj < 2; ++bj) { const int col = cb + bj * 128;
                    const f32x4 v0 = *(const gf32x4*)(ip + col) + acc[ai][bj][m][0], v1 = *(const gf32x4*)(ip + col + 4) + acc[ai][bj][m][1];
                    *(gf32x4*)(op + col) = v0; *(gf32x4*)(op + col + 4) = v1;
                    *(gu32x4*)(XB + (size_t)row * 1024 + col) = pack8(v0, v1);
                    sq += (v0[0] * v0[0] + v0[1] * v0[1]) + (v0[2] * v0[2] + v0[3] * v0[3]) + (v1[0] * v1[0] + v1[1] * v1[1]) + (v1[2] * v1[2] + v1[3] * v1[3]); }
                sq += __shfl_xor(sq, 16); sq += __shfl_xor(sq, 32);
                if (fq == 0) ssout[(size_t)u.pn * (M_PAD * 4) + (size_t)row * 4 + wc] = sq; }
    }
};
struct EpiFfn {
    static constexpr bool PERM = true, AFTER_DRAIN = false;
    const gfloat* ss; bf16_t* HM;
    __device__ __forceinline__ void operator()(const f32x4 (&acc)[2][2][4][2], const Unit& u, int wr, int wc, int fr, int fq) const {
        int cb = wc * 32 + 8 * fq; asm volatile("" : "+v"(cb), "+v"(fr)); cb += u.pn * 128;
#pragma unroll
        for (int ai = 0; ai < 2; ++ai)
#pragma unroll
            for (int m = 0; m < 4; ++m) { const int row = u.pm * 256 + ai * 128 + wr * 64 + m * 16 + fr; const float rs = row_rs(ss, row);
                f32x4 h[2];
#pragma unroll
                for (int n = 0; n < 2; ++n) { const f32x4 g = acc[ai][0][m][n] * rs, up = acc[ai][1][m][n] * rs;
#pragma unroll
                    for (int j = 0; j < 4; ++j) h[n][j] = g[j] * sigmoidf_(g[j]) * up[j]; }
                *(gu32x4*)(HM + (size_t)row * DFF + cb) = pack8(h[0], h[1]); }
    }
};
}

__device__ __forceinline__ float wave_sum(float v) {
#pragma unroll
    for (int o = 1; o < 64; o <<= 1) v += __shfl_xor(v, o);
    return v;
}
__device__ __forceinline__ void p0a_fold(const float* w_in, const float* mix, const float* scale, float* wut, int gtid, int nthr) {
    for (int o = gtid; o < DEPTH * 1024 * 512; o += nthr) {
        const int n = o & 511, k = (o >> 9) & 1023, l = o >> 19, g = n >> 7, d = n & 127;
        const float* wr = w_in + ((size_t)l * 1024 + k) * NIN + 1536 + g * 128;
        const float* mx = mix + ((size_t)(l * 4 + g) * 128) * 128 + d;
        float s = 0.f;
#pragma unroll 8
        for (int c = 0; c < 128; ++c) s += wr[c] * mx[(size_t)c * 128];
        wut[o] = s * scale[l * 512 + n];
    }
}
__device__ __forceinline__ void tr_item(const float* src, int ld, int c0, const float* gk, int k0, bf16* WT, int K, int drow0, LAS float* scr, int lane) {
#pragma unroll 8
    for (int i = 0; i < 32; ++i) { const int kk = 2 * i + (lane >> 5); float v = src[(size_t)(k0 + kk) * ld + c0 + (lane & 31)]; if (gk) v *= gk[k0 + kk]; scr[kk * 33 + (lane & 31)] = v; }
    LDS_WAIT(); asm volatile("" ::: "memory");
    const int c = lane & 7;
#pragma unroll
    for (int j = 0; j < 4; ++j) { const int n = (lane >> 3) + 8 * j; const LAS float* s = scr + (8 * c) * 33 + n;
        v4u o; o.x = pk2(s[0 * 33], s[1 * 33]); o.y = pk2(s[2 * 33], s[3 * 33]); o.z = pk2(s[4 * 33], s[5 * 33]); o.w = pk2(s[6 * 33], s[7 * 33]);
        *(GAS v4u*)(WT + (size_t)(drow0 + n) * K + k0 + 8 * c) = o; }
    LDS_WAIT(); asm volatile("" ::: "memory");
}
struct In14 { const float *x, *meta, *g1, *w_in, *b_gate, *mix, *scale, *wbp, *wbs, *wout, *g2, *wf1, *wf2, *gf; };
__device__ __forceinline__ void p0b_weights(const In14& I, unsigned char* ws, LAS float* scr, int gw, int ngw, int lane) {
    constexpr int I_IN = 16 * 128, I_BP = 8 * 32, I_OUT = 16 * 32, I_F1 = 16 * 176, I_F2 = 44 * 32, I_L = I_IN + 2 * I_BP + I_OUT + I_F1 + I_F2;
    for (int it = gw; it < DEPTH * I_L; it += ngw) {
        const int l = it / I_L; int r = it % I_L;
        if (r < I_IN) { const int kb = r >> 7, nb = r & 127, n0 = nb * 32; const bool fold = (n0 >= 1536 && n0 < 2048);
            const float* src = fold ? (const float*)(ws + WS_WUT) + (size_t)l * 1024 * 512 : I.w_in + (size_t)l * 1024 * NIN;
            tr_item(src, fold ? 512 : NIN, fold ? n0 - 1536 : n0, I.g1 + l * 1024, kb * 64, (bf16*)(ws + WS_WIN) + (size_t)l * NIN * 1024, 1024, n0, scr, lane); continue; }
        r -= I_IN;
        if (r < I_BP) { const int kb = r >> 5, nb = r & 31; tr_item(I.wbp + (size_t)l * 512 * 1024, 1024, nb * 32, nullptr, kb * 64, (bf16*)(ws + WS_WBP) + (size_t)l * 1024 * 512, 512, nb * 32, scr, lane); continue; }
        r -= I_BP;
        if (r < I_BP) { const int kb = r >> 5, nb = r & 31; tr_item(I.wbs + (size_t)l * 512 * 1024, 1024, nb * 32, nullptr, kb * 64, (bf16*)(ws + WS_WBS) + (size_t)l * 1024 * 512, 512, nb * 32, scr, lane); continue; }
        r -= I_BP;
        if (r < I_OUT) { const int kb = r >> 5, nb = r & 31; tr_item(I.wout + (size_t)l * 1024 * 1024, 1024, nb * 32, nullptr, kb * 64, (bf16*)(ws + WS_WOUT) + (size_t)l * 1024 * 1024, 1024, nb * 32, scr, lane); continue; }
        r -= I_OUT;
        if (r < I_F1) { const int kb = r / 176, jb = r % 176, j0 = jb * 32, pn = j0 >> 8, jj = j0 & 255; const int c0 = jj < 128 ? pn * 128 + jj : DFF + pn * 128 + (jj - 128);
            tr_item(I.wf1 + (size_t)l * 1024 * NF1, NF1, c0, I.g2 + l * 1024, kb * 64, (bf16*)(ws + WS_WF1) + (size_t)l * NF1 * 1024, 1024, j0, scr, lane); continue; }
        r -= I_F1;
        { const int kb = r >> 5, nb = r & 31; tr_item(I.wf2 + (size_t)l * DFF * 1024, 1024, nb * 32, nullptr, kb * 64, (bf16*)(ws + WS_WF2) + (size_t)l * 1024 * DFF, DFF, nb * 32, scr, lane); }
    }
}
__device__ __forceinline__ void p0b_rows(const In14& I, unsigned char* ws, int gw, int ngw, int lane) {
    for (int row = gw; row < M_PAD; row += ngw) {
        const float* src = row < M_MAIN ? I.x + (size_t)row * D : (row < M_MAIN + NMETA ? I.meta + (size_t)(row - M_MAIN) * D : nullptr);
        f32x4 v[4]; float s = 0.f;
#pragma unroll
        for (int j = 0; j < 4; ++j) { v[j] = src ? ((const GAS f32x4*)src)[64 * j + lane] : (f32x4){0.f, 0.f, 0.f, 0.f}; s += (v[j].x * v[j].x + v[j].y * v[j].y) + (v[j].z * v[j].z + v[j].w * v[j].w); }
        s = wave_sum(s);
        GAS unsigned long long* o8 = (GAS unsigned long long*)((bf16*)(ws + WS_XB) + (size_t)row * D) + lane;
#pragma unroll
        for (int j = 0; j < 4; ++j) o8[64 * j] = (unsigned long long)pk2(v[j].x, v[j].y) | ((unsigned long long)pk2(v[j].z, v[j].w) << 32);
        if (lane < 16) ((float*)(ws + WS_SSA))[(size_t)(lane >> 2) * (M_PAD * 4) + (size_t)row * 4 + (lane & 3)] = lane == 0 ? s : 0.f;
        if (row >= M_MAIN) { GAS f32x4* xm = (GAS f32x4*)((float*)(ws + WS_XM) + (size_t)(row - M_MAIN) * D);
#pragma unroll
            for (int j = 0; j < 4; ++j) xm[64 * j + lane] = v[j]; }
    }
}
__device__ __forceinline__ float bf_lo(unsigned w) { return __uint_as_float(w << 16); }
__device__ __forceinline__ float bf_hi(unsigned w) { return __uint_as_float(w & 0xffff0000u); }
__device__ __forceinline__ void pool_filter(const bf16* U, bf16* A, int gtid, int nthr) {
    for (int w = gtid; w < (M_MAIN + NMETA) * 64; w += nthr) {
        const int c8 = w & 63, i = w >> 6; int b, p;
        if (i < M_MAIN) { b = i >> 11; p = NMETA + (i & 2047); } else { b = 0; p = i - M_MAIN; }
        const int win = 2 << (c8 >> 4), cnt = (p + 1 < win) ? p + 1 : win;
        const bf16* up = U + (size_t)(b * LTOT + p) * 512 + c8 * 8;
        float a[8], cur[8];
#pragma unroll
        for (int e = 0; e < 8; ++e) a[e] = 0.f;
        for (int j = 0; j < cnt; ++j) { const v4u v = *(const GAS v4u*)(up - (size_t)j * 512);
            const float f[8] = {bf_lo(v.x), bf_hi(v.x), bf_lo(v.y), bf_hi(v.y), bf_lo(v.z), bf_hi(v.z), bf_lo(v.w), bf_hi(v.w)};
#pragma unroll
            for (int e = 0; e < 8; ++e) { a[e] += f[e]; if (j == 0) cur[e] = f[e]; } }
        const float inv = 1.0f / (float)cnt;
        v4u o; o.x = pk2(a[0] * inv - cur[0], a[1] * inv - cur[1]); o.y = pk2(a[2] * inv - cur[2], a[3] * inv - cur[3]);
        o.z = pk2(a[4] * inv - cur[4], a[5] * inv - cur[5]); o.w = pk2(a[6] * inv - cur[6], a[7] * inv - cur[7]);
        *(GAS v4u*)(A + (size_t)i * 512 + c8 * 8) = o;
    }
}
template <bool META_ONLY> __device__ __forceinline__ void attn_simple(const bf16* Q, const bf16* K, const bf16* V, bf16* S, int gw, int ngw, int lane) {
    for (int it = META_ONLY ? NB * NH * (SEQ / 64) + gw : gw; it < NB * NH * (SEQ / 64) + NH; it += ngw) {
        int b, h, p, qrow, smax;
        if (it < NB * NH * (SEQ / 64)) { const int bh = it >> 5, qc = it & 31; b = bh >> 3; h = bh & 7; const int t = qc * 64 + lane; p = NMETA + t; qrow = b * SEQ + t; smax = NMETA + qc * 64 + 63; }
        else { h = it - NB * NH * (SEQ / 64); b = 0; p = lane < NMETA ? lane : 0; qrow = M_MAIN + (lane < NMETA ? lane : 0); smax = NMETA; }
        float q[64], o[64];
        { const GAS v4u* qp = (const GAS v4u*)(Q + (size_t)qrow * 512 + h * 64);
#pragma unroll
          for (int c = 0; c < 8; ++c) { const v4u v = qp[c]; q[8 * c + 0] = bf_lo(v.x); q[8 * c + 1] = bf_hi(v.x); q[8 * c + 2] = bf_lo(v.y); q[8 * c + 3] = bf_hi(v.y); q[8 * c + 4] = bf_lo(v.z); q[8 * c + 5] = bf_hi(v.z); q[8 * c + 6] = bf_lo(v.w); q[8 * c + 7] = bf_hi(v.w); } }
#pragma unroll
        for (int d = 0; d < 64; ++d) o[d] = 0.f;
        float I = 1.0f;
        for (int s = smax - 1; s >= 0; --s) {
#if EARLY_EXIT
            if (!__any(I != 0.0f)) break;
#endif
            int soff = (b * LTOT + s) * 512 + h * 64; asm volatile("" : "+v"(soff));
            const GAS v4u* kp = (const GAS v4u*)(K + soff); const GAS v4u* vp = (const GAS v4u*)(V + soff);
            float z = 0.f;
#pragma unroll
            for (int c = 0; c < 8; ++c) { const v4u v = kp[c];
                z += q[8 * c + 0] * bf_lo(v.x) + q[8 * c + 1] * bf_hi(v.x) + q[8 * c + 2] * bf_lo(v.y) + q[8 * c + 3] * bf_hi(v.y) + q[8 * c + 4] * bf_lo(v.z) + q[8 * c + 5] * bf_hi(v.z) + q[8 * c + 6] * bf_lo(v.w) + q[8 * c + 7] * bf_hi(v.w); }
            float m = __builtin_amdgcn_rcpf(1.0f + __builtin_amdgcn_exp2f(z));
            if (s >= p) m = 1.0f;
            const float In = I * m, w = I - In; I = In;
#pragma unroll
            for (int c = 0; c < 8; ++c) { const v4u v = vp[c];
                o[8 * c + 0] += w * bf_lo(v.x); o[8 * c + 1] += w * bf_hi(v.x); o[8 * c + 2] += w * bf_lo(v.y); o[8 * c + 3] += w * bf_hi(v.y); o[8 * c + 4] += w * bf_lo(v.z); o[8 * c + 5] += w * bf_hi(v.z); o[8 * c + 6] += w * bf_lo(v.w); o[8 * c + 7] += w * bf_hi(v.w); }
        }
        if (it < NB * NH * (SEQ / 64) || lane < NMETA) { GAS v4u* sp = (GAS v4u*)(S + (size_t)qrow * 512 + h * 64);
#pragma unroll
            for (int c = 0; c < 8; ++c) { v4u w; w.x = pk2(o[8 * c + 0], o[8 * c + 1]); w.y = pk2(o[8 * c + 2], o[8 * c + 3]); w.z = pk2(o[8 * c + 4], o[8 * c + 5]); w.w = pk2(o[8 * c + 6], o[8 * c + 7]); sp[c] = w; } }
    }
}
namespace sba {
typedef short bf16x8 __attribute__((ext_vector_type(8)));
typedef float f32x16 __attribute__((ext_vector_type(16)));
typedef short v4i16_t __attribute__((ext_vector_type(4)));
typedef float f32x2_t __attribute__((ext_vector_type(2))); typedef __bf16 bf16x2_t __attribute__((ext_vector_type(2)));
__device__ __forceinline__ unsigned cvtpk(float lo, float hi) { f32x2_t v = {lo, hi}; bf16x2_t b = __builtin_convertvector(v, bf16x2_t); return __builtin_bit_cast(unsigned, b); }
__device__ __forceinline__ int crow(int r, int hi) { return (r & 3) + 8 * (r >> 2) + 4 * hi; }
__device__ __forceinline__ bf16x8 vfrag(LAS const unsigned char* p) {
    const v4i16_t lo = __builtin_amdgcn_ds_read_tr16_b64_v4i16((LAS v4i16_t*)p), hi = __builtin_amdgcn_ds_read_tr16_b64_v4i16((LAS v4i16_t*)(p + 8 * 128));
    return (bf16x8){lo[0], lo[1], lo[2], lo[3], hi[0], hi[1], hi[2], hi[3]};
}
#define SBA_BLOCK(x0, x1, x2, x3, Sv) do { const float P3_ = x3 * (Sv), P2_ = x2 * (Sv), P1_ = x1 * (Sv), P0_ = x0 * (Sv); x3 = (Sv) - P3_; x2 = P3_ - P2_; x1 = P2_ - P1_; x0 = P1_ - P0_; } while (0)
__device__ __forceinline__ void unit(const bf16* Q, const bf16* K, const bf16* V, bf16* S, int b, int h, int qi, LAS unsigned char* vl, int lane) {
    const int ql = lane & 31, hi = lane >> 5;
    const int t0 = 32 * qi, qrow = b * SEQ + t0 + ql, kend = NMETA + t0 + 32;
    bf16x8 qf[4];
    { const GAS bf16x8* qp = (const GAS bf16x8*)(Q + (size_t)qrow * 512 + h * 64 + 8 * hi);
#pragma unroll
      for (int ks = 0; ks < 4; ++ks) qf[ks] = qp[2 * ks]; }
    f32x16 o0, o1;
#pragma unroll
    for (int r = 0; r < 16; ++r) { o0[r] = 0.f; o1[r] = 0.f; }
    float R = 1.0f;
    const bf16* Kb = K + (size_t)b * LTOT * 512 + h * 64; const bf16* Vb = V + (size_t)b * LTOT * 512 + h * 64;
    const int g4 = lane >> 4, i16 = lane & 15;
    LAS const unsigned char* vrd = vl + (4 * hi + (i16 >> 2)) * 128 + (16 * (g4 & 1) + 4 * (i16 & 3)) * 2;
    for (int ts = kend - 64;; ts -= 64) {
        bf16x8 kf[2][4];
#pragma unroll
        for (int blk = 0; blk < 2; ++blk) { int row = ts + 32 * blk + ql; row = row < 0 ? 0 : row;
            const GAS bf16x8* kp = (const GAS bf16x8*)(Kb + (size_t)row * 512 + 8 * hi);
#pragma unroll
            for (int ks = 0; ks < 4; ++ks) kf[blk][ks] = kp[2 * ks]; }
        { int row = ts + lane; row = row < 0 ? 0 : row; const GAS v4u* vp = (const GAS v4u*)(Vb + (size_t)row * 512);
#pragma unroll
          for (int c = 0; c < 8; ++c) { const int ch = (c + lane) & 7; const v4u v = vp[ch]; *(LAS v4u*)(vl + lane * 128 + ch * 16) = v; } }
        f32x16 p0, p1;
#pragma unroll
        for (int r = 0; r < 16; ++r) { p0[r] = 0.f; p1[r] = 0.f; }
#pragma unroll
        for (int ks = 0; ks < 4; ++ks) { p0 = __builtin_amdgcn_mfma_f32_32x32x16_bf16(kf[0][ks], qf[ks], p0, 0, 0, 0); p1 = __builtin_amdgcn_mfma_f32_32x32x16_bf16(kf[1][ks], qf[ks], p1, 0, 0, 0); }
#pragma unroll
        for (int r = 0; r < 16; ++r) { p0[r] = __builtin_amdgcn_rcpf(1.0f + __builtin_amdgcn_exp2f(p0[r])); p1[r] = __builtin_amdgcn_rcpf(1.0f + __builtin_amdgcn_exp2f(p1[r])); }
        if (ts == kend - 64) {
#pragma unroll
            for (int r = 0; r < 16; ++r) if (crow(r, hi) >= ql) p1[r] = 1.0f;
        }
        if (ts < 0) {
#pragma unroll
            for (int r = 0; r < 16; ++r) { if (crow(r, hi) < -ts) p0[r] = 1.0f; if (32 + crow(r, hi) < -ts) p1[r] = 1.0f; }
        }
        float U[8], Pn[8];
#pragma unroll
        for (int g = 0; g < 4; ++g) { p0[4 * g + 2] *= p0[4 * g + 3]; p0[4 * g + 1] *= p0[4 * g + 2]; p0[4 * g] *= p0[4 * g + 1];
                                      p1[4 * g + 2] *= p1[4 * g + 3]; p1[4 * g + 1] *= p1[4 * g + 2]; p1[4 * g] *= p1[4 * g + 1]; }
#pragma unroll
        for (int g = 0; g < 8; ++g) { const float T = g < 4 ? p0[4 * g] : p1[4 * (g - 4)];
            const auto rr = __builtin_amdgcn_permlane32_swap(__float_as_uint(T), __float_as_uint(T), false, false);
            const float a = __uint_as_float(rr[0]), c = __uint_as_float(rr[1]);
            U[g] = a * c;
            Pn[g] = hi ? 1.0f : c;
        }
        float E = R;
#pragma unroll
        for (int g = 7; g >= 0; --g) { const float Sg = E * Pn[g]; E *= U[g];
            if (g < 4) SBA_BLOCK(p0[4 * g], p0[4 * g + 1], p0[4 * g + 2], p0[4 * g + 3], Sg);
            else SBA_BLOCK(p1[4 * (g - 4)], p1[4 * (g - 4) + 1], p1[4 * (g - 4) + 2], p1[4 * (g - 4) + 3], Sg); }
        R = E;
        bf16x8 wf[2][2];
#pragma unroll
        for (int s2 = 0; s2 < 2; ++s2) {
            const v4u a = {cvtpk(p0[8 * s2], p0[8 * s2 + 1]), cvtpk(p0[8 * s2 + 2], p0[8 * s2 + 3]), cvtpk(p0[8 * s2 + 4], p0[8 * s2 + 5]), cvtpk(p0[8 * s2 + 6], p0[8 * s2 + 7])};
            const v4u c = {cvtpk(p1[8 * s2], p1[8 * s2 + 1]), cvtpk(p1[8 * s2 + 2], p1[8 * s2 + 3]), cvtpk(p1[8 * s2 + 4], p1[8 * s2 + 5]), cvtpk(p1[8 * s2 + 6], p1[8 * s2 + 7])};
            wf[0][s2] = __builtin_bit_cast(bf16x8, a); wf[1][s2] = __builtin_bit_cast(bf16x8, c); }
#pragma unroll
        for (int blk = 0; blk < 2; ++blk)
#pragma unroll
            for (int s2 = 0; s2 < 2; ++s2) { LAS const unsigned char* vp = vrd + (32 * blk + 16 * s2) * 128;
                o0 = __builtin_amdgcn_mfma_f32_32x32x16_bf16(vfrag(vp), wf[blk][s2], o0, 0, 0, 0);
                o1 = __builtin_amdgcn_mfma_f32_32x32x16_bf16(vfrag(vp + 64), wf[blk][s2], o1, 0, 0, 0); }
        if (ts <= 0) break;
#if EARLY_EXIT
        if (!__any(R != 0.0f)) break;
#endif
    }
    GAS unsigned long long* sp = (GAS unsigned long long*)(S + (size_t)qrow * 512 + h * 64 + 4 * hi);
#pragma unroll
    for (int g = 0; g < 4; ++g) {
        sp[2 * g] = (unsigned long long)cvtpk(o0[4 * g], o0[4 * g + 1]) | ((unsigned long long)cvtpk(o0[4 * g + 2], o0[4 * g + 3]) << 32);
        sp[8 + 2 * g] = (unsigned long long)cvtpk(o1[4 * g], o1[4 * g + 1]) | ((unsigned long long)cvtpk(o1[4 * g + 2], o1[4 * g + 3]) << 32); }
}
#undef SBA_BLOCK
__device__ __forceinline__ void phase(const bf16* Q, const bf16* K, const bf16* V, bf16* S, LAS unsigned char* lds, int gw, int ngw, int wave, int lane) {
    LAS unsigned char* vl = lds + wave * 8192;
    for (int w = gw; w < NB * NH * 32; w += ngw) { const int bh = w >> 5, j = w & 31;
#pragma unroll 1
        for (int rep = 0; rep < 2; ++rep) unit(Q, K, V, S, bh >> 3, bh & 7, rep ? 63 - j : j, vl, lane); }
}
}
namespace meta {
typedef short bf16x8 __attribute__((ext_vector_type(8)));
typedef float f32x4 __attribute__((ext_vector_type(4)));
typedef GAS unsigned short gbf;
__device__ __forceinline__ float bfv(short h) { return __uint_as_float((unsigned)(unsigned short)h << 16); }
__device__ __forceinline__ float sigm(float x) { return __builtin_amdgcn_rcpf(1.0f + __builtin_amdgcn_exp2f(-LOG2E * x)); }
template <bool TWO, bool SUMSQ>
__device__ __forceinline__ void strip_mma(const bf16* A0, const bf16* B0, const bf16* A1, const bf16* B1, int K, int lane, f32x4& acc0, f32x4& acc1, float& ssq) {
    const int r = lane & 15, kq = lane >> 4;
    const GAS bf16x8* a0 = (const GAS bf16x8*)(A0 + (size_t)r * K + 8 * kq); const GAS bf16x8* b0 = (const GAS bf16x8*)(B0 + (size_t)r * K + 8 * kq);
    const GAS bf16x8* a1 = (const GAS bf16x8*)(A1 + (size_t)r * K + 8 * kq); const GAS bf16x8* b1 = (const GAS bf16x8*)(B1 + (size_t)r * K + 8 * kq);
    acc0 = (f32x4){0.f, 0.f, 0.f, 0.f}; acc1 = (f32x4){0.f, 0.f, 0.f, 0.f}; float q = 0.f;
#pragma unroll 4
    for (int it = 0; it < K / 32; ++it) {
        const bf16x8 a = a0[4 * it], b = b0[4 * it];
        acc0 = __builtin_amdgcn_mfma_f32_16x16x32_bf16(a, b, acc0, 0, 0, 0);
        if (SUMSQ) {
#pragma unroll
            for (int j = 0; j < 8; ++j) { const float v = bfv(a[j]); q += v * v; } }
        if (TWO) { const bf16x8 c = (A1 == A0) ? a : a1[4 * it], d = b1[4 * it]; acc1 = __builtin_amdgcn_mfma_f32_16x16x32_bf16(c, d, acc1, 0, 0, 0); }
    }
    if (SUMSQ) { q += __shfl_xor(q, 16); q += __shfl_xor(q, 32); }
    ssq = q;
}
struct Ptrs { unsigned char* ws; const float* bias; int l; };
__device__ __forceinline__ void in_proj(const Ptrs& P, int bx, int wave, int lane) {
    const int cu = 255 - bx; if (cu >= 32) return; const int s = cu * 8 + wave, n0 = s * 16;
    const bf16* A = (const bf16*)(P.ws + WS_XB) + (size_t)M_MAIN * 1024; const bf16* B = (const bf16*)(P.ws + WS_WIN) + (size_t)P.l * NIN * 1024 + (size_t)n0 * 1024;
    f32x4 acc, dummy; float ssq; strip_mma<false, true>(A, B, A, B, 1024, lane, acc, dummy, ssq);
    const float rsr = __builtin_amdgcn_rsqf(ssq * (1.0f / 1024.0f) + RMS_EPS);
    const int col = lane & 15, n = n0 + col, r0 = 4 * (lane >> 4);
#pragma unroll
    for (int i = 0; i < 4; ++i) { const int row = r0 + i; const float rs = __shfl(rsr, row); const float v = acc[i] * rs;
        if (n < 512) ((gbf*)(P.ws + WS_Q))[(size_t)(M_MAIN + row) * 512 + n] = (unsigned short)f2bf(v * QSCALE);
        else if (n < 2048) { const int t = (n >> 9) % 3; gbf* base = (gbf*)(P.ws + WS_U + (size_t)t * ACT16); const unsigned short hv = (unsigned short)f2bf(v);
#pragma unroll
            for (int b2 = 0; b2 < NB; ++b2) base[(size_t)(b2 * LTOT + row) * 512 + (n & 511)] = hv; }
        else ((gbf*)(P.ws + WS_G))[(size_t)(M_MAIN + row) * 2048 + (n - 2048)] = (unsigned short)f2bf(sigm(v + P.bias[n - 2048])); }
}
__device__ __forceinline__ void branches(const Ptrs& P, int bx, int wave, int lane) {
    const int cu = 255 - bx; if (cu >= 8) return; const int s = cu * 8 + wave, n0 = s * 16;
    const bf16* A0 = (const bf16*)(P.ws + WS_A) + (size_t)M_MAIN * 512; const bf16* A1 = (const bf16*)(P.ws + WS_S) + (size_t)M_MAIN * 512;
    const bf16* B0 = (const bf16*)(P.ws + WS_WBP) + (size_t)P.l * 1024 * 512 + (size_t)n0 * 512; const bf16* B1 = (const bf16*)(P.ws + WS_WBS) + (size_t)P.l * 1024 * 512 + (size_t)n0 * 512;
    f32x4 ap, as; float ssq; strip_mma<true, false>(A0, B0, A1, B1, 512, lane, ap, as, ssq);
    const int n = n0 + (lane & 15), r0 = 4 * (lane >> 4); const gbf* G = (const gbf*)(P.ws + WS_G);
#pragma unroll
    for (int i = 0; i < 4; ++i) { const size_t row = M_MAIN + r0 + i; const float gp = bfv((short)G[row * 2048 + n]), gs = bfv((short)G[row * 2048 + 1024 + n]);
        ((gbf*)(P.ws + WS_MG))[row * 1024 + n] = (unsigned short)f2bf(gp * ap[i] + gs * as[i]); }
}
__device__ __forceinline__ void residual(const Ptrs& P, const bf16* A, const bf16* Bt, int K, int bx, int wave, int lane) {
    const int cu = 255 - bx; if (cu >= 8) return; const int s = cu * 8 + wave, n0 = s * 16;
    f32x4 acc, dummy; float ssq; strip_mma<false, false>(A, Bt + (size_t)n0 * K, A, Bt, K, lane, acc, dummy, ssq);
    const int n = n0 + (lane & 15), r0 = 4 * (lane >> 4); GAS float* xm = (GAS float*)(P.ws + WS_XM);
#pragma unroll
    for (int i = 0; i < 4; ++i) { const int row = r0 + i; const float v = xm[(size_t)row * 1024 + n] + acc[i]; xm[(size_t)row * 1024 + n] = v;
        ((gbf*)(P.ws + WS_XB))[(size_t)(M_MAIN + row) * 1024 + n] = (unsigned short)f2bf(v); }
}
__device__ __forceinline__ void ffn_in(const Ptrs& P, int bx, int wave, int lane) {
    const int cu = 255 - bx; if (cu >= 22) return; const int s = cu * 8 + wave, c0 = s * 16, pn = c0 >> 7, jj = c0 & 127;
    const bf16* A = (const bf16*)(P.ws + WS_XB) + (size_t)M_MAIN * 1024; const bf16* Bg = (const bf16*)(P.ws + WS_WF1) + (size_t)P.l * NF1 * 1024 + (size_t)(pn * 256 + jj) * 1024;
    f32x4 ag, au; float ssq; strip_mma<true, true>(A, Bg, A, Bg + (size_t)128 * 1024, 1024, lane, ag, au, ssq);
    const float rsr = __builtin_amdgcn_rsqf(ssq * (1.0f / 1024.0f) + RMS_EPS);
    const int c = c0 + (lane & 15), r0 = 4 * (lane >> 4);
#pragma unroll
    for (int i = 0; i < 4; ++i) { const int row = r0 + i; const float rs = __shfl(rsr, row); const float g = ag[i] * rs, u = au[i] * rs;
        ((gbf*)(P.ws + WS_HM))[(size_t)(M_MAIN + row) * DFF + c] = (unsigned short)f2bf(g * sigm(g) * u); }
}
}

__device__ __forceinline__ void final_norm(float* out, const float* gf, int gw, int ngw, int lane) {
    f32x4 g[4];
#pragma unroll
    for (int j = 0; j < 4; ++j) g[j] = ((const GAS f32x4*)gf)[64 * j + lane];
    for (int row = gw; row < M_MAIN; row += ngw) {
        GAS f32x4* xr = (GAS f32x4*)(out + (size_t)row * D); f32x4 v[4]; float s = 0.f;
#pragma unroll
        for (int j = 0; j < 4; ++j) { v[j] = xr[64 * j + lane]; s += (v[j].x * v[j].x + v[j].y * v[j].y) + (v[j].z * v[j].z + v[j].w * v[j].w); }
        const float rs = 1.0f / sqrtf(wave_sum(s) * (1.0f / D) + RMS_EPS);
#pragma unroll
        for (int j = 0; j < 4; ++j) xr[64 * j + lane] = v[j] * rs * g[j];
    }
}

constexpr int N_PHASES = 15;
struct Args { const float* in[14]; float* out; unsigned char* ws; int ph_lo, ph_hi; };
__global__ void __launch_bounds__(NWAVES * 64, 2) fwd_kernel(Args args) {
    extern __shared__ __attribute__((aligned(16))) unsigned char lds[];
    LAS unsigned char* L = (LAS unsigned char*)lds;
    volatile LAS unsigned* MISC = (volatile LAS unsigned*)(L + MISC_OFF);
    const int G = gridDim.x, bx = blockIdx.x, vcu = (G % 8 == 0) ? (bx % 8) * (G / 8) + bx / 8 : bx;
    const int ngw = G * NWAVES, nthr = G * NWAVES * 64;
#define LANE_VARS int tid = threadIdx.x; asm volatile("" : "+v"(tid)); const int lane = tid & 63, wave = __builtin_amdgcn_readfirstlane(tid >> 6), gw = vcu * NWAVES + wave, gtid = bx * (NWAVES * 64) + tid; (void)lane; (void)gw; (void)gtid;
    unsigned char* ws = args.ws;
    gu32* ctl = (gu32*)(ws + WS_CTL);
    In14 I; I.x = args.in[0]; I.meta = args.in[1]; I.g1 = args.in[2]; I.w_in = args.in[3]; I.b_gate = args.in[4]; I.mix = args.in[5]; I.scale = args.in[6];
    I.wbp = args.in[7]; I.wbs = args.in[8]; I.wout = args.in[9]; I.g2 = args.in[10]; I.wf1 = args.in[11]; I.wf2 = args.in[12]; I.gf = args.in[13];
    float* out = args.out;
    for (int u = threadIdx.x; u < (LDS_BYTES - LDSCTL_OFF) / 4; u += NWAVES * 64) ((LAS unsigned*)(L + LDSCTL_OFF))[u] = 0u;
    __syncthreads();
    const int lo = args.ph_lo, hi = args.ph_hi;
    const bool multi = (hi - lo) > 1;
    XcdBarrier bar; bar.bar = (unsigned*)(ctl + CW_BAR); bar.x = 0; bar.st = nullptr;
    if (multi) bar = xcd_barrier_post((unsigned*)(ctl + CW_BAR), MISC + 8);
#define IN(k) (lo <= (k) && (k) < hi)
#define SEAM(k) do { if (IN(k) && IN((k) + 1)) xcd_barrier(bar); } while (0)
    if (IN(0)) { LANE_VARS p0a_fold(I.w_in, I.mix, I.scale, (float*)(ws + WS_WUT), gtid, nthr); }
    SEAM(0);
    if (IN(1)) { LANE_VARS p0b_weights(I, ws, (LAS float*)(L + RING_OFF + wave * 16384), gw, ngw, lane); p0b_rows(I, ws, gw, ngw, lane); }
    SEAM(1);
    for (int l = 0; l < DEPTH; ++l) {
        const int pb = 2 + 6 * l;
        unsigned char* w = ws; int bxl = bx, Gl = G; asm volatile("" : "+s"(w), "+s"(bxl), "+s"(Gl));
#define WB(off) ((bf16*)(w + (off)))
#define WG(off) ((GAS bf16*)(w + (off)))
#define WF(off) ((GAS float*)(w + (off)))
        if (IN(pb + 0)) {
            { LANE_VARS meta::Ptrs MP{w, I.b_gate + l * 2048, l}; meta::in_proj(MP, bxl, wave, lane); }
            pg8::Gemm g{WB(WS_XB), WB(WS_WIN) + (size_t)l * NIN * 1024, M_PAD, NIN, 1024}; pg8::StaticOrder S; S.init(M_MAIN, NIN, Gl, bxl);
            epi::EpiIn E{WG(WS_Q), WG(WS_U), WG(WS_G), WF(WS_SSA), (const GAS float*)(I.b_gate + l * 2048)};
            pg8::gemm_phase<epi::EpiIn, pg8::StaticOrder, PG8_ALIGN, PG8_SP2>(L + RING_OFF, g, S, E);
        }
        SEAM(pb + 0);
        if (IN(pb + 1)) { LANE_VARS pool_filter(WB(WS_U), WB(WS_A), gtid, nthr); sba::phase(WB(WS_Q), WB(WS_K), WB(WS_V), WB(WS_S), L + RING_OFF, gw, ngw, wave, lane); attn_simple<true>(WB(WS_Q), WB(WS_K), WB(WS_V), WB(WS_S), gw, ngw, lane); }
        SEAM(pb + 1);
        if (IN(pb + 2)) {
            if (l == 0) { LANE_VARS meta::Ptrs MP{w, nullptr, l}; meta::branches(MP, bxl, wave, lane); }
            { pg8::Gemm g{WB(WS_A), WB(WS_WBP) + (size_t)l * 1024 * 512, M_PAD, 1024, 512}; pg8::StaticOrder S; S.init(M_MAIN, 1024, Gl, bxl);
              epi::EpiBrA E{WG(WS_G), WG(WS_MP)}; pg8::gemm_phase<epi::EpiBrA, pg8::StaticOrder, PG8_ALIGN, PG8_SP2>(L + RING_OFF, g, S, E); }
            { pg8::Gemm g{WB(WS_S), WB(WS_WBS) + (size_t)l * 1024 * 512, M_PAD, 1024, 512}; pg8::StaticOrder S; S.init(M_MAIN, 1024, Gl, bxl);
              epi::EpiBrB E{WG(WS_G), WG(WS_MP), WG(WS_MG)}; pg8::gemm_phase<epi::EpiBrB, pg8::StaticOrder, PG8_ALIGN, PG8_SP2>(L + RING_OFF, g, S, E); }
        }
        SEAM(pb + 2);
        if (IN(pb + 3)) {
            if (l == 0) { LANE_VARS meta::Ptrs MP{w, nullptr, l}; meta::residual(MP, WB(WS_MG) + (size_t)M_MAIN * 1024, WB(WS_WOUT) + (size_t)l * 1024 * 1024, 1024, bxl, wave, lane); }
            pg8::Gemm g{WB(WS_MG), WB(WS_WOUT) + (size_t)l * 1024 * 1024, M_PAD, 1024, 1024}; pg8::StaticOrder S; S.init(M_MAIN, 1024, Gl, bxl);
            epi::EpiRes E{(const GAS float*)(l == 0 ? I.x : out), (GAS float*)out, WF(WS_XM), WG(WS_XB), WF(WS_SSB)};
            pg8::gemm_phase<epi::EpiRes, pg8::StaticOrder, PG8_ALIGN, PG8_SP2>(L + RING_OFF, g, S, E);
        }
        SEAM(pb + 3);
        if (IN(pb + 4)) {
            if (l == 0) { LANE_VARS meta::Ptrs MP{w, nullptr, l}; meta::ffn_in(MP, bxl, wave, lane); }
            pg8::Gemm g{WB(WS_XB), WB(WS_WF1) + (size_t)l * NF1 * 1024, M_PAD, NF1, 1024}; pg8::StaticOrder S; S.init(M_MAIN, NF1, Gl, bxl);
            epi::EpiFfn E{WF(WS_SSB), WG(WS_HM)};
            pg8::gemm_phase<epi::EpiFfn, pg8::StaticOrder, PG8_ALIGN, PG8_SP2>(L + RING_OFF, g, S, E);
        }
        SEAM(pb + 4);
        if (IN(pb + 5)) {
            if (l == 0) { LANE_VARS meta::Ptrs MP{w, nullptr, l}; meta::residual(MP, WB(WS_HM) + (size_t)M_MAIN * DFF, WB(WS_WF2) + (size_t)l * 1024 * DFF, DFF, bxl, wave, lane); }
            pg8::Gemm g{WB(WS_HM), WB(WS_WF2) + (size_t)l * 1024 * DFF, M_PAD, 1024, DFF}; pg8::StaticOrder S; S.init(M_MAIN, 1024, Gl, bxl);
            epi::EpiRes E{(const GAS float*)out, (GAS float*)out, WF(WS_XM), WG(WS_XB), WF(WS_SSA)};
            pg8::gemm_phase<epi::EpiRes, pg8::StaticOrder, PG8_ALIGN, PG8_SP2>(L + RING_OFF, g, S, E);
        }
        SEAM(pb + 5);
#undef WB
#undef WG
#undef WF
    }
    if (IN(14)) { LANE_VARS final_norm(out, I.gf, gw, ngw, lane); }
#undef LANE_VARS
#undef IN
#undef SEAM
}

#if defined(DUMP_AFTER)
#ifndef DUMP_LIST
#define DUMP_LIST {WS_G, (size_t)M_PAD * 2048}, {WS_Q, (size_t)M_PAD * 512}, {WS_K, (size_t)NB * LTOT * 512}, {WS_V, (size_t)NB * LTOT * 512}, {WS_U, (size_t)NB * LTOT * 512}
#endif
#ifndef DUMP_F32
#define DUMP_F32 {WS_SSA, (size_t)M_PAD * 16}
#endif
#ifndef DUMP_FSCALE
#define DUMP_FSCALE 0.f
#endif
struct DumpEnt { size_t off, cnt; };
__global__ void dump_kernel(const unsigned char* ws, float* out) {
    const DumpEnt L[] = {DUMP_LIST}; const DumpEnt F[] = {DUMP_F32};
    for (size_t i = (size_t)blockIdx.x * blockDim.x + threadIdx.x; i < (size_t)M_MAIN * D; i += (size_t)gridDim.x * blockDim.x) {
        float v = 0.f;
        for (unsigned j = 0; j < sizeof(L) / sizeof(L[0]); ++j) { const unsigned short h = ((const unsigned short*)(ws + L[j].off))[i % L[j].cnt]; v += __uint_as_float((unsigned)h << 16); }
        for (unsigned j = 0; j < sizeof(F) / sizeof(F[0]); ++j) v += DUMP_FSCALE * ((const float*)(ws + F[j].off))[i % F[j].cnt];
        out[i] = v;
    }
}
#endif
#ifndef MK_LAUNCH_PER_PHASE
#define MK_LAUNCH_PER_PHASE 1
#endif
extern "C" void kernel_launch(void* const* d_in, const int* in_sizes, int n_in, void* d_out, int out_size, void* d_ws, size_t ws_size, hipStream_t stream) {
    static int grid = 0;
    if (grid == 0) {
        if (n_in != 14 || in_sizes[0] != M_MAIN * D || out_size != M_MAIN * D || ws_size < WS_WUT + 4 * MiB) { fprintf(stderr, "kernel_launch: unexpected shapes: n_in %d in0 %d out %d ws %zu (need %zu)\n", n_in, n_in > 0 ? in_sizes[0] : -1, out_size, ws_size, (size_t)WS_END); grid = -1; return; }
        int dev = 0, cus = 0, per_cu = 0;
        if (hipGetDevice(&dev) != hipSuccess || hipDeviceGetAttribute(&cus, hipDeviceAttributeMultiprocessorCount, dev) != hipSuccess) { fprintf(stderr, "kernel_launch: device query failed\n"); grid = -1; return; }
        if (hipFuncSetAttribute((const void*)fwd_kernel, hipFuncAttributeMaxDynamicSharedMemorySize, LDS_BYTES) != hipSuccess) { fprintf(stderr, "kernel_launch: hipFuncSetAttribute failed\n"); grid = -1; return; }
        if (hipOccupancyMaxActiveBlocksPerMultiprocessor(&per_cu, (const void*)fwd_kernel, NWAVES * 64, LDS_BYTES) != hipSuccess || per_cu < 1)
            fprintf(stderr, "kernel_launch: note: occupancy query reports %d workgroups per CU\n", per_cu);
        (void)hipGetLastError();
        grid = cus;
    }
    if (grid < 0) return;
    if (hipMemsetAsync((char*)d_ws + WS_CTL, 0, CTL_ZERO_BYTES, stream) != hipSuccess) { fprintf(stderr, "kernel_launch: memset failed\n"); return; }
    Args a{};
    for (int i = 0; i < 14; ++i) a.in[i] = (const float*)d_in[i];
    a.out = (float*)d_out; a.ws = (unsigned char*)d_ws;
#if defined(DUMP_AFTER)
    for (int p = 0; p <= DUMP_AFTER; ++p) { a.ph_lo = p; a.ph_hi = p + 1; hipLaunchKernelGGL(fwd_kernel, dim3(grid), dim3(NWAVES * 64), LDS_BYTES, stream, a); }
    hipLaunchKernelGGL(dump_kernel, dim3(2048), dim3(256), 0, stream, (const unsigned char*)d_ws, (float*)d_out);
#elif MK_LAUNCH_PER_PHASE
    for (int p = 0; p < N_PHASES; ++p) { a.ph_lo = p; a.ph_hi = p + 1; hipLaunchKernelGGL(fwd_kernel, dim3(grid), dim3(NWAVES * 64), LDS_BYTES, stream, a); }
#else
    a.ph_lo = 0; a.ph_hi = N_PHASES; hipLaunchKernelGGL(fwd_kernel, dim3(grid), dim3(NWAVES * 64), LDS_BYTES, stream, a);
#endif
    const hipError_t le = hipPeekAtLastError();
    if (le != hipSuccess) fprintf(stderr, "kernel_launch: launch failed: %s\n", hipGetErrorName(le));
}
```

```cpp
#define MK_LAUNCH_PER_PHASE 0
#include <hip/hip_runtime.h>
#include <cstdio>
#include <cstdint>
namespace pg8 {
#define PG8_LAS __attribute__((address_space(3)))
typedef unsigned short bf16_t;
typedef short bf16x8 __attribute__((ext_vector_type(8)));
typedef float f32x4 __attribute__((ext_vector_type(4)));
typedef unsigned u32x4 __attribute__((ext_vector_type(4)));
constexpr int BM = 256, BK = 64, HALF = 128, HTB = HALF * BK * 2  , STAGE_BYTES = 8 * HTB, NXCD = 8, WGM = 8;

__host__ __device__ __forceinline__ int lds_byte(int r, int c) { const int st = (r >> 4) * 2 + (c >> 5), rr = r & 15, cc = c & 31, ob = rr * 64 + cc * 2; return st * 1024 + (ob ^ (((ob >> 9) & 1) << 5)); }
__host__ __device__ __forceinline__ void stage_rc(int b, int& R, int& C) { const int st = b / 1024, sb = b % 1024, swz = sb ^ (((sb >> 9) & 1) << 5); R = (st >> 1) * 16 + swz / 64; C = (st & 1) * 32 + (swz % 64) / 2; }
__host__ __device__ __forceinline__ int perm32(int rho) { const int n = rho >> 4, i = rho & 15; return 8 * (i >> 2) + 4 * n + (i & 3); }

struct Unit { int pm, pn; };
struct Gemm { const bf16_t* A; const bf16_t* Bt; int M, N, K; };

struct StaticOrder {
    int nM, nN, nwg, G, c;
    __host__ __device__ void init(int M, int N, int G_, int c_) { nM = M / BM; nN = N / BM; nwg = nM * nN; G = G_; c = c_; }
    __host__ __device__ bool next(int i, Unit& u) const {
        const long L = (long)i * G + c; if (L >= nwg) return false;
        int wgid = (int)L; { const int q = nwg / NXCD, r = nwg % NXCD, xcd = wgid % NXCD, off = wgid / NXCD; wgid = (xcd < r ? xcd * (q + 1) : r * (q + 1) + (xcd - r) * q) + off; }
        const int nig = WGM * nN, gid = wgid / nig, fm = gid * WGM, gsz = (nM - fm) < WGM ? (nM - fm) : WGM;
        u.pm = fm + ((wgid % nig) % gsz); u.pn = (wgid % nig) / gsz; return true;
    }
    __device__ __forceinline__ void a_ready(const Unit&) const {}
    __device__ __forceinline__ void done(const Unit&) const {}
};

__device__ __forceinline__ unsigned cvt_pk_bf16(float lo, float hi) { unsigned r; asm volatile("v_cvt_pk_bf16_f32 %0, %1, %2" : "=v"(r) : "v"(lo), "v"(hi)); return r; }
template <class Epi, class Sched, bool ALIGN_EPI = false, bool SP2 = false>
__device__ __forceinline__ void gemm_phase(PG8_LAS unsigned char* lds, const Gemm g, const Sched& S, const Epi& E) {
    int tid = threadIdx.x; asm volatile("" : "+v"(tid));
    const int wid = __builtin_amdgcn_readfirstlane(tid >> 6), lane = tid & 63, wr = wid >> 2, wc = wid & 3, fr = lane & 15, fq = lane >> 4;
    const int K = g.K, nt = K / BK;
    unsigned voffA[2], voffB[2];
#pragma unroll
    for (int i = 0; i < 2; ++i) { int R, C; stage_rc(tid * 16 + i * 8192, R, C); const int Rb = Epi::PERM ? ((R & ~31) + perm32(R & 31)) : R;
        voffA[i] = (unsigned)(R * K + C) * 2u; voffB[i] = (unsigned)(Rb * K + C) * 2u; }
    const size_t kstep = (size_t)(BK * 2);
    const size_t hstep = (size_t)HALF * K * 2;
    const size_t tstep = 2 * hstep;
    const unsigned ldsw = (unsigned)wid * 1024u;
    const int aoff = lds_byte(wr * 64 + fr, fq * 8), boff = lds_byte(wc * 32 + fr, fq * 8);
#define PG8_SA(b, h) (((b) * 2 + (h)) * HTB)
#define PG8_SB(b, h) ((4 + (b) * 2 + (h)) * HTB)
#define PG8_STAGE(bufoff, gbase, voff) do { _Pragma("unroll") for (int _i = 0; _i < 2; ++_i) \
        __builtin_amdgcn_global_load_lds((const unsigned*)((const char*)(gbase) + (voff)[_i]), (PG8_LAS unsigned*)(lds + (bufoff) + ldsw + _i * 8192), 16, 0, 0); } while (0)
#define PG8_LDA(dst, b, h) do { _Pragma("unroll") for (int m = 0; m < 4; ++m) _Pragma("unroll") for (int k = 0; k < 2; ++k) dst[m][k] = *(const PG8_LAS bf16x8*)(lds + PG8_SA(b, h) + aoff + m * 2048 + k * 1024); } while (0)
#define PG8_LDB(dst, b, h) do { _Pragma("unroll") for (int n = 0; n < 2; ++n) _Pragma("unroll") for (int k = 0; k < 2; ++k) dst[n][k] = *(const PG8_LAS bf16x8*)(lds + PG8_SB(b, h) + boff + n * 2048 + k * 1024); } while (0)
#define PG8_MMA(ai, bj, At, Bt) do { __builtin_amdgcn_s_setprio(1); _Pragma("unroll") for (int m = 0; m < 4; ++m) _Pragma("unroll") for (int n = 0; n < 2; ++n) _Pragma("unroll") for (int k = 0; k < 2; ++k) \
        acc[ai][bj][m][n] = __builtin_amdgcn_mfma_f32_16x16x32_bf16(Bt[n][k], At[m][k], acc[ai][bj][m][n], 0, 0, 0); __builtin_amdgcn_s_setprio(0); } while (0)
#define PG8_WAIT_V(n) asm volatile("s_waitcnt vmcnt(" #n ")" ::: "memory")
#define PG8_WAIT_L(n) asm volatile("s_waitcnt lgkmcnt(" #n ")" ::: "memory")
#define PG8_BAR __builtin_amdgcn_s_barrier()
#define PG8_SCHED __builtin_amdgcn_sched_barrier(0)
    Unit cur, nxt; int ui = 0;
    if (!S.next(0, cur)) return;
    f32x4 acc[2][2][4][2];
#pragma unroll
    for (int a = 0; a < 2; ++a)
#pragma unroll
        for (int b = 0; b < 2; ++b)
#pragma unroll
            for (int m = 0; m < 4; ++m)
#pragma unroll
                for (int n = 0; n < 2; ++n) acc[a][b][m][n] = (f32x4){0.f, 0.f, 0.f, 0.f};
    bf16x8 At[4][2], B0[2][2], B1[2][2];
    const char* cA = (const char*)g.A + (size_t)cur.pm * tstep; const char* cB = (const char*)g.Bt + (size_t)cur.pn * tstep;
    S.a_ready(cur);
    if constexpr (SP2) {
        PG8_STAGE(PG8_SB(0, 0), cB, voffB); PG8_STAGE(PG8_SB(0, 1), cB + hstep, voffB); PG8_STAGE(PG8_SA(0, 0), cA, voffA); PG8_STAGE(PG8_SA(0, 1), cA + hstep, voffA);
        if (wr == 1) PG8_BAR;
        PG8_WAIT_V(2); PG8_BAR;
        PG8_STAGE(PG8_SB(1, 0), cB + kstep, voffB); PG8_STAGE(PG8_SA(1, 0), cA + kstep, voffA); PG8_STAGE(PG8_SB(1, 1), cB + hstep + kstep, voffB);
        PG8_WAIT_V(6); PG8_BAR;
    } else {
        PG8_STAGE(PG8_SB(0, 0), cB, voffB); PG8_STAGE(PG8_SA(0, 0), cA, voffA); PG8_STAGE(PG8_SB(0, 1), cB + hstep, voffB); PG8_STAGE(PG8_SA(0, 1), cA + hstep, voffA);
        if (wr == 1) PG8_BAR;
        PG8_WAIT_V(4); PG8_BAR;
        PG8_STAGE(PG8_SB(1, 0), cB + kstep, voffB); PG8_STAGE(PG8_SA(1, 0), cA + kstep, voffA); PG8_STAGE(PG8_SB(1, 1), cB + hstep + kstep, voffB);
        PG8_WAIT_V(6); PG8_BAR;
    }
    for (;;) {
        const bool has_next = S.next(ui + 1, nxt);
        const char* nA = has_next ? (const char*)g.A + (size_t)nxt.pm * tstep : cA; const char* nB = has_next ? (const char*)g.Bt + (size_t)nxt.pn * tstep : cB;
        for (int t = 0; t < nt; t += 2) {
            const bool last = (t == nt - 2);
            const char* a1 = cA + (size_t)(t + 1) * kstep;
            const char* a2 = last ? nA : cA + (size_t)(t + 2) * kstep; const char* b2 = last ? nB : cB + (size_t)(t + 2) * kstep;
            const char* a3 = a2 + kstep; const char* b3 = b2 + kstep;
            if (last && has_next) S.a_ready(nxt);
            if constexpr (SP2) {
            PG8_LDB(B0, 0, 0); PG8_LDB(B1, 0, 1); PG8_SCHED; PG8_LDA(At, 0, 0); PG8_STAGE(PG8_SA(1, 1), a1 + hstep, voffA);
            PG8_WAIT_V(8); PG8_WAIT_L(0); PG8_BAR; PG8_MMA(0, 0, At, B0); PG8_MMA(0, 1, At, B1); PG8_BAR; PG8_SCHED;
            PG8_LDA(At, 0, 1); PG8_STAGE(PG8_SB(0, 0), b2, voffB); PG8_STAGE(PG8_SB(0, 1), b2 + hstep, voffB); PG8_STAGE(PG8_SA(0, 0), a2, voffA);
            PG8_WAIT_V(8); PG8_WAIT_L(0); PG8_BAR; PG8_MMA(1, 0, At, B0); PG8_MMA(1, 1, At, B1); PG8_BAR; PG8_SCHED;
            PG8_LDB(B0, 1, 0); PG8_LDB(B1, 1, 1); PG8_SCHED; PG8_LDA(At, 1, 0); PG8_STAGE(PG8_SA(0, 1), a2 + hstep, voffA);
            PG8_WAIT_V(8); PG8_WAIT_L(0); PG8_BAR; PG8_MMA(0, 0, At, B0); PG8_MMA(0, 1, At, B1); PG8_BAR; PG8_SCHED;
            PG8_LDA(At, 1, 1); PG8_STAGE(PG8_SB(1, 0), b3, voffB); PG8_STAGE(PG8_SB(1, 1), b3 + hstep, voffB); PG8_STAGE(PG8_SA(1, 0), a3, voffA);
            PG8_WAIT_V(8); PG8_WAIT_L(0); PG8_BAR; PG8_MMA(1, 0, At, B0); PG8_MMA(1, 1, At, B1); PG8_BAR; PG8_SCHED;
            } else {
            PG8_LDB(B0, 0, 0); PG8_SCHED; PG8_LDA(At, 0, 0); PG8_STAGE(PG8_SA(1, 1), a1 + hstep, voffA);
            PG8_WAIT_L(8); PG8_BAR; PG8_WAIT_L(0); PG8_MMA(0, 0, At, B0); PG8_BAR; PG8_SCHED;
            PG8_LDB(B1, 0, 1); PG8_STAGE(PG8_SB(0, 0), b2, voffB);
            PG8_BAR; PG8_WAIT_L(0); PG8_MMA(0, 1, At, B1); PG8_BAR;
            PG8_LDA(At, 0, 1); PG8_STAGE(PG8_SA(0, 0), a2, voffA);
            PG8_BAR; PG8_WAIT_L(0); PG8_MMA(1, 0, At, B0); PG8_BAR; PG8_SCHED;
            PG8_STAGE(PG8_SB(0, 1), b2 + hstep, voffB);
            PG8_WAIT_V(6); PG8_BAR; PG8_MMA(1, 1, At, B1); PG8_BAR;
            PG8_LDB(B0, 1, 0); PG8_SCHED; PG8_LDA(At, 1, 0); PG8_STAGE(PG8_SA(0, 1), a2 + hstep, voffA);
            PG8_WAIT_L(8); PG8_BAR; PG8_WAIT_L(0); PG8_MMA(0, 0, At, B0); PG8_BAR; PG8_SCHED;
            PG8_LDB(B1, 1, 1); PG8_STAGE(PG8_SB(1, 0), b3, voffB);
            PG8_BAR; PG8_WAIT_L(0); PG8_MMA(0, 1, At, B1); PG8_BAR;
            PG8_LDA(At, 1, 1); PG8_STAGE(PG8_SA(1, 0), a3, voffA);
            PG8_BAR; PG8_WAIT_L(0); PG8_MMA(1, 0, At, B0); PG8_BAR; PG8_SCHED;
            PG8_STAGE(PG8_SB(1, 1), b3 + hstep, voffB);
            PG8_WAIT_V(6); PG8_BAR; PG8_MMA(1, 1, At, B1); PG8_BAR;
            }
        }
        if constexpr (ALIGN_EPI) { if (wr == 0) PG8_BAR; }
        if constexpr (!Epi::AFTER_DRAIN) { E(acc, cur, wr, wc, fr, fq); S.done(cur); }
        if (!has_next) break;
#pragma unroll
        for (int a = 0; a < 2; ++a)
#pragma unroll
            for (int b = 0; b < 2; ++b)
#pragma unroll
                for (int m = 0; m < 4; ++m)
#pragma unroll
                    for (int n = 0; n < 2; ++n) acc[a][b][m][n] = (f32x4){0.f, 0.f, 0.f, 0.f};
        cur = nxt; cA = nA; cB = nB; ++ui;
        if constexpr (ALIGN_EPI) { if (wr == 1) PG8_BAR; }
    }
    PG8_WAIT_V(0);
    if constexpr (!ALIGN_EPI) { if (wr == 0) PG8_BAR; }
    PG8_BAR;
    if constexpr (Epi::AFTER_DRAIN) { E.fused(acc, cur, wr, wc, fr, fq, lds, wid, lane); S.done(cur); }
#undef PG8_SA
#undef PG8_SB
#undef PG8_STAGE
#undef PG8_LDA
#undef PG8_LDB
#undef PG8_MMA
#undef PG8_WAIT_V
#undef PG8_WAIT_L
#undef PG8_BAR
#undef PG8_SCHED
}
}

#ifndef PG8_SP2
#define PG8_SP2 true
#endif
#ifndef PG8_ALIGN
#define PG8_ALIGN true
#endif

constexpr int NWAVES = 8;
constexpr int D = 1024, NB = 8, SEQ = 2048, NMETA = 16, LTOT = SEQ + NMETA, DEPTH = 2;
constexpr int M_MAIN = NB * SEQ;
constexpr int M_PAD = M_MAIN + 256;
constexpr int NIN = 4096, NH = 8, HD = 64, DFF = 2816, NF1 = 2 * DFF;
constexpr float RMS_EPS = 1e-6f;
constexpr float LOG2E = 1.4426950408889634f;
constexpr float QSCALE = 0.125f * LOG2E;
#ifndef EARLY_EXIT
#define EARLY_EXIT 1
#endif

constexpr size_t MiB = 1u << 20;
constexpr size_t WS_CTL = 0, CTL_ZERO_BYTES = 1 * MiB;
constexpr size_t WS_WIN = 1 * MiB;
constexpr size_t WS_WBP = 17 * MiB;
constexpr size_t WS_WBS = 19 * MiB;
constexpr size_t WS_WOUT = 21 * MiB;
constexpr size_t WS_WF1 = 25 * MiB;
constexpr size_t WS_WF2 = 47 * MiB;
constexpr size_t WS_SSA = 58 * MiB;
constexpr size_t WS_SSB = WS_SSA + 1280 * 1024;
constexpr size_t WS_XM = WS_SSB + 1280 * 1024;
constexpr size_t WS_XB = 62 * MiB;
constexpr size_t ACT16 = (size_t)M_PAD * 512 * 2;
constexpr size_t WS_Q = WS_XB + 2 * ACT16;
constexpr size_t WS_U = WS_Q + ACT16, WS_K = WS_U + ACT16, WS_V = WS_K + ACT16, WS_G = WS_V + ACT16;
static_assert(WS_K == WS_U + ACT16 && WS_V == WS_U + 2 * ACT16, "EpiIn addresses K and V relative to U");
constexpr size_t WS_MP = WS_Q, WS_MG = WS_K, WS_HM = WS_Q;
constexpr size_t WS_END = WS_G + 4 * ACT16;
constexpr size_t WS_WUT = WS_END;
static_assert(WS_XM + 1 * MiB <= WS_XB && WS_WF2 + 11 * MiB <= WS_SSA && WS_WUT + 4 * MiB <= 256 * MiB, "d_ws map");
static_assert(WS_HM + (size_t)M_PAD * DFF * 2 <= WS_END, "HM overlay");
constexpr int CW_TMO = 0, CW_CODE = 1;
constexpr int CW_BAR = 4096;

constexpr int RING_OFF = 0, RING_BYTES = 131072;
constexpr int LDSCTL_OFF = RING_BYTES, MISC_OFF = LDSCTL_OFF + 320;
constexpr int LDS_BYTES = 147456;
static_assert(MISC_OFF + 128 <= LDS_BYTES, "LDS map");
#define GAS __attribute__((address_space(1)))
#define LAS __attribute__((address_space(3)))
typedef unsigned short bf16;
typedef unsigned v4u __attribute__((ext_vector_type(4)));
typedef float f32x4 __attribute__((ext_vector_type(4)));
typedef short bf16x8 __attribute__((ext_vector_type(8)));
typedef GAS unsigned gu32;
typedef GAS unsigned long long gu64;
#define RLX_AGENT __ATOMIC_RELAXED, __HIP_MEMORY_SCOPE_AGENT
#define LDS_WAIT() asm volatile("s_waitcnt lgkmcnt(0)" ::: "memory")
#define VM_WAIT() asm volatile("s_waitcnt vmcnt(0)" ::: "memory")
__device__ __forceinline__ unsigned long long rt() { return __builtin_amdgcn_s_memrealtime(); }
__device__ __forceinline__ unsigned f2bf(float f) { unsigned u = __builtin_bit_cast(unsigned, f); return (u + 0x7fffu + ((u >> 16) & 1u)) >> 16; }
__device__ __forceinline__ unsigned pk2(float lo, float hi) { return f2bf(lo) | (f2bf(hi) << 16); }

#define XB_TMO      128
#define XB_XCNT(j)  (256  + 64 * (j))
#define XB_XSUB(j)  (1280 + 64 * (j))
#define XB_XGEN(j)  (2304 + 64 * (j))
#define XB_TOP      3328
#define XB_TOPGEN   3392
#define XCD_BAR_WORDS 3456
#define XB_SPIN_CAP (1u << 18)

__device__ __forceinline__ unsigned xb_ld(unsigned* p)              { return __hip_atomic_load(p, __ATOMIC_RELAXED, __HIP_MEMORY_SCOPE_AGENT); }
__device__ __forceinline__ unsigned xb_add(unsigned* p, unsigned v) { return __hip_atomic_fetch_add(p, v, __ATOMIC_RELAXED, __HIP_MEMORY_SCOPE_AGENT); }
__device__ __forceinline__ unsigned xb_xcc_id() { return (unsigned)__builtin_amdgcn_s_getreg((3 << 11) | 20) & 0xFu; }
#define XB_SPIN(cond, bar) do { unsigned _sp = 0; while (cond) { __builtin_amdgcn_s_sleep(1); \
    if ((++_sp & 255u) == 0u) { if (xb_ld(&(bar)[XB_TMO])) break; if (_sp > XB_SPIN_CAP) { atomicAdd(&(bar)[XB_TMO], 1u); break; } } } } while (0)

struct XcdBarrier {
    unsigned* bar; unsigned x;
    volatile LAS unsigned* st;
};

__device__ __forceinline__ XcdBarrier xcd_barrier_post(unsigned* bar, volatile LAS unsigned* st) {
    XcdBarrier b; b.bar = bar; b.x = xb_xcc_id(); b.st = st;
    if (threadIdx.x == 0) (void)xb_add(&bar[XB_XCNT(b.x)], 1u);
    return b;
}
__device__ __forceinline__ void xcd_barrier_complete(unsigned* bar, unsigned x, unsigned& nloc, unsigned& nx) {
    const unsigned G = gridDim.x * gridDim.y * gridDim.z;
    unsigned sum, cnt, mine, sp = 0u;
    for (;;) {
        sum = 0u; cnt = 0u; mine = 0u;
#pragma unroll
        for (unsigned j = 0; j < 16; ++j) { const unsigned c = xb_ld(&bar[XB_XCNT(j)]); sum += c; cnt += (c > 0u) ? 1u : 0u; mine = (j == x) ? c : mine; }
        if (sum == G) break;
        __builtin_amdgcn_s_sleep(1);
        if ((++sp & 255u) == 0u) { if (xb_ld(&bar[XB_TMO])) break; if (sp > XB_SPIN_CAP) { atomicAdd(&bar[XB_TMO], 1u); break; } }
    }
    nloc = mine > 0u ? mine : 1u; nx = cnt > 0u ? cnt : 1u;
}

__device__ __forceinline__ void xcd_barrier(const XcdBarrier& b) {
    asm volatile("s_waitcnt vmcnt(0)" ::: "memory");
    __syncthreads();
    if (threadIdx.x == 0) {
        unsigned* bar = b.bar;
        __builtin_amdgcn_s_waitcnt(0);
        unsigned nloc = b.st[0], nx = b.st[1];
        if (nloc == 0u) { xcd_barrier_complete(bar, b.x, nloc, nx); b.st[0] = nloc; b.st[1] = nx; }
        const unsigned old = xb_add(&bar[XB_XSUB(b.x)], 1u);
        const unsigned gen = old / nloc;
        if (old + 1u == (gen + 1u) * nloc) {
            __builtin_amdgcn_fence(__ATOMIC_RELEASE, "agent");
            asm volatile("s_waitcnt vmcnt(0)" ::: "memory");
            const unsigned og = xb_add(&bar[XB_TOP], 1u);
            const unsigned tg = og / nx;
            if (og + 1u == (tg + 1u) * nx) xb_add(&bar[XB_TOPGEN], 1u);
            else XB_SPIN(xb_ld(&bar[XB_TOPGEN]) == tg, bar);
            __builtin_amdgcn_fence(__ATOMIC_ACQUIRE, "agent");
            xb_add(&bar[XB_XGEN(b.x)], 1u);
            asm volatile("s_waitcnt vmcnt(0)" ::: "memory");
        } else {
            XB_SPIN(xb_ld(&bar[XB_XGEN(b.x)]) == gen, bar);
            __builtin_amdgcn_fence(__ATOMIC_ACQUIRE, "agent");
            asm volatile("s_waitcnt vmcnt(0)" ::: "memory");
        }
    }
    __syncthreads();
}


namespace epi {
using pg8::f32x4; using pg8::u32x4; using pg8::Unit;
typedef float f32x2_t __attribute__((ext_vector_type(2))); typedef __bf16 bf16x2_t __attribute__((ext_vector_type(2)));
__device__ __forceinline__ unsigned cvt_pk_bf16(float lo, float hi) { f32x2_t v = {lo, hi}; bf16x2_t b = __builtin_convertvector(v, bf16x2_t); return __builtin_bit_cast(unsigned, b); }
typedef GAS unsigned short bf16_t;
typedef GAS float gfloat; typedef GAS f32x4 gf32x4; typedef GAS u32x4 gu32x4;
__device__ __forceinline__ float row_rs(const gfloat* ss, int row) {
    const gf32x4* sp = (const gf32x4*)(ss + (size_t)row * 4);
    const f32x4 a = sp[0], b = sp[M_PAD], c = sp[2 * M_PAD], d = sp[3 * M_PAD];
    const f32x4 t = (a + b) + (c + d);
    const float s = (t[0] + t[1]) + (t[2] + t[3]);
    return __builtin_amdgcn_rsqf(s * (1.0f / 1024.0f) + RMS_EPS);
}
__device__ __forceinline__ float sigmoidf_(float x) { return __builtin_amdgcn_rcpf(1.0f + __builtin_amdgcn_exp2f(-LOG2E * x)); }
__device__ __forceinline__ u32x4 pack8(const f32x4 v0, const f32x4 v1) { u32x4 w; w.x = cvt_pk_bf16(v0[0], v0[1]); w.y = cvt_pk_bf16(v0[2], v0[3]); w.z = cvt_pk_bf16(v1[0], v1[1]); w.w = cvt_pk_bf16(v1[2], v1[3]); return w; }
__device__ __forceinline__ void unpack8(const u32x4 w, f32x4& v0, f32x4& v1) {
    v0[0] = __uint_as_float(w.x << 16); v0[1] = __uint_as_float(w.x & 0xffff0000u); v0[2] = __uint_as_float(w.y << 16); v0[3] = __uint_as_float(w.y & 0xffff0000u);
    v1[0] = __uint_as_float(w.z << 16); v1[1] = __uint_as_float(w.z & 0xffff0000u); v1[2] = __uint_as_float(w.w << 16); v1[3] = __uint_as_float(w.w & 0xffff0000u);
}

struct EpiIn {
    static constexpr bool PERM = true, AFTER_DRAIN = false;
    bf16_t *Q, *UKV, *G; const gfloat* ss; const gfloat* bias;
    __device__ __forceinline__ void operator()(const f32x4 (&acc)[2][2][4][2], const Unit& u, int wr, int wc, int fr, int fq) const {
        int cb = wc * 32 + 8 * fq; asm volatile("" : "+v"(cb), "+v"(fr)); const int pn = u.pn, pm = u.pm;
        if (pn < 2) {
#pragma unroll
            for (int ai = 0; ai < 2; ++ai)
#pragma unroll
                for (int m = 0; m < 4; ++m) { const int row = pm * 256 + ai * 128 + wr * 64 + m * 16 + fr; const float rs = row_rs(ss, row) * QSCALE;
                    bf16_t* rp = Q + (size_t)row * 512 + pn * 256 + cb;
#pragma unroll
                    for (int bj = 0; bj < 2; ++bj) *(gu32x4*)(rp + bj * 128) = pack8(acc[ai][bj][m][0] * rs, acc[ai][bj][m][1] * rs); }
        } else if (pn < 8) {
            bf16_t* base = UKV + (size_t)((pn >> 1) % 3) * (ACT16 / 2); const int c0 = (pn & 1) * 256 + cb;
            if (pm < 64) {
#pragma unroll
                for (int ai = 0; ai < 2; ++ai)
#pragma unroll
                    for (int m = 0; m < 4; ++m) { const int row = pm * 256 + ai * 128 + wr * 64 + m * 16 + fr; const float rs = row_rs(ss, row);
                        const int drow = row + 16 * ((row >> 11) + 1);
                        bf16_t* rp = base + (size_t)drow * 512 + c0;
#pragma unroll
                        for (int bj = 0; bj < 2; ++bj) *(gu32x4*)(rp + bj * 128) = pack8(acc[ai][bj][m][0] * rs, acc[ai][bj][m][1] * rs); }
            } else if (wr == 0) {
                const float rs = row_rs(ss, M_MAIN + fr);
#pragma unroll
                for (int bj = 0; bj < 2; ++bj) { const u32x4 w = pack8(acc[0][bj][0][0] * rs, acc[0][bj][0][1] * rs);
#pragma unroll
                    for (int b2 = 0; b2 < NB; ++b2) *(gu32x4*)(base + (size_t)(b2 * LTOT + fr) * 512 + c0 + bj * 128) = w; }
            }
        } else {
            const int gc = (pn - 8) * 256 + cb;
            f32x4 bv[2][2];
#pragma unroll
            for (int bj = 0; bj < 2; ++bj)
#pragma unroll
                for (int n = 0; n < 2; ++n) bv[bj][n] = *(const gf32x4*)(bias + gc + bj * 128 + 4 * n);
#pragma unroll
            for (int ai = 0; ai < 2; ++ai)
#pragma unroll
                for (int m = 0; m < 4; ++m) { const int row = pm * 256 + ai * 128 + wr * 64 + m * 16 + fr; const float rs = row_rs(ss, row);
                    bf16_t* rp = G + (size_t)row * 2048 + gc;
#pragma unroll
                    for (int bj = 0; bj < 2; ++bj) { f32x4 v0 = acc[ai][bj][m][0] * rs + bv[bj][0], v1 = acc[ai][bj][m][1] * rs + bv[bj][1];
#pragma unroll
                        for (int j = 0; j < 4; ++j) { v0[j] = sigmoidf_(v0[j]); v1[j] = sigmoidf_(v1[j]); }
                        *(gu32x4*)(rp + bj * 128) = pack8(v0, v1); } }
        }
    }
};
struct EpiBrA {
    static constexpr bool PERM = true, AFTER_DRAIN = false;
    const bf16_t* G; bf16_t* MP;
    __device__ __forceinline__ void operator()(const f32x4 (&acc)[2][2][4][2], const Unit& u, int wr, int wc, int fr, int fq) const {
        int cb = wc * 32 + 8 * fq; asm volatile("" : "+v"(cb), "+v"(fr)); cb += u.pn * 256;
#pragma unroll
        for (int ai = 0; ai < 2; ++ai)
#pragma unroll
            for (int m = 0; m < 4; ++m) { const int row = u.pm * 256 + ai * 128 + wr * 64 + m * 16 + fr;
#pragma unroll
                for (int bj = 0; bj < 2; ++bj) { const int col = cb + bj * 128; f32x4 g0, g1; unpack8(*(const gu32x4*)(G + (size_t)row * 2048 + col), g0, g1);
                    *(gu32x4*)(MP + (size_t)row * 1024 + col) = pack8(acc[ai][bj][m][0] * g0, acc[ai][bj][m][1] * g1); } }
    }
};
struct EpiBrB {
    static constexpr bool PERM = true, AFTER_DRAIN = false;
    const bf16_t* G; const bf16_t* MP; bf16_t* MG;
    __device__ __forceinline__ void operator()(const f32x4 (&acc)[2][2][4][2], const Unit& u, int wr, int wc, int fr, int fq) const {
        int cb = wc * 32 + 8 * fq; asm volatile("" : "+v"(cb), "+v"(fr)); cb += u.pn * 256;
#pragma unroll
        for (int ai = 0; ai < 2; ++ai)
#pragma unroll
            for (int m = 0; m < 4; ++m) { const int row = u.pm * 256 + ai * 128 + wr * 64 + m * 16 + fr;
#pragma unroll
                for (int bj = 0; bj < 2; ++bj) { const int col = cb + bj * 128; f32x4 g0, g1, p0, p1;
                    unpack8(*(const gu32x4*)(G + (size_t)row * 2048 + 1024 + col), g0, g1); unpack8(*(const gu32x4*)(MP + (size_t)row * 1024 + col), p0, p1);
                    *(gu32x4*)(MG + (size_t)row * 1024 + col) = pack8(p0 + acc[ai][bj][m][0] * g0, p1 + acc[ai][bj][m][1] * g1); } }
    }
};
template <bool FINAL> struct EpiRes {
    static constexpr bool PERM = true, AFTER_DRAIN = false;
    bf16_t* XB; gfloat* ssout; gfloat* xout;
    __device__ __forceinline__ void operator()(const f32x4 (&acc)[2][2][4][2], const Unit& u, int wr, int wc, int fr, int fq) const {
        int cb = wc * 32 + 8 * fq; asm volatile("" : "+v"(cb), "+v"(fr)); cb += u.pn * 256;
#pragma unroll
        for (int ai = 0; ai < 2; ++ai)
#pragma unroll
            for (int m = 0; m < 4; ++m) { const int row = u.pm * 256 + ai * 128 + wr * 64 + m * 16 + fr;
                float sq = 0.f;
#pragma unroll
                for (int bj = 0; bj < 2; ++bj) { const int col = cb + bj * 128; f32x4 x0, x1; unpack8(*(const gu32x4*)(XB + (size_t)row * 1024 + col), x0, x1);
                    const f32x4 v0 = x0 + acc[ai][bj][m][0], v1 = x1 + acc[ai][bj][m][1];
                    if (FINAL) { *(gf32x4*)(xout + (size_t)row * 1024 + col) = v0; *(gf32x4*)(xout + (size_t)row * 1024 + col + 4) = v1; }
                    else { *(gu32x4*)(XB + (size_t)row * 1024 + col) = pack8(v0, v1);
                        sq += (v0[0] * v0[0] + v0[1] * v0[1]) + (v0[2] * v0[2] + v0[3] * v0[3]) + (v1[0] * v1[0] + v1[1] * v1[1]) + (v1[2] * v1[2] + v1[3] * v1[3]); } }
                if (!FINAL) { sq += __shfl_xor(sq, 16); sq += __shfl_xor(sq, 32);
                    if (fq == 0) ssout[(size_t)u.pn * (M_PAD * 4) + (size_t)row * 4 + wc] = sq; } }
    }
};
struct EpiFfn {
    static constexpr bool PERM = true, AFTER_DRAIN = false;
    const gfloat* ss; bf16_t* HM;
    __device__ __forceinline__ void operator()(const f32x4 (&acc)[2][2][4][2], const Unit& u, int wr, int wc, int fr, int fq) const {
        int cb = wc * 32 + 8 * fq; asm volatile("" : "+v"(cb), "+v"(fr)); cb += u.pn * 128;
#pragma unroll
        for (int ai = 0; ai < 2; ++ai)
#pragma unroll
            for (int m = 0; m < 4; ++m) { const int row = u.pm * 256 + ai * 128 + wr * 64 + m * 16 + fr; const float rs = row_rs(ss, row);
                f32x4 h[2];
#pragma unroll
                for (int n = 0; n < 2; ++n) { const f32x4 g = acc[ai][0][m][n] * rs, up = acc[ai][1][m][n] * rs;
#pragma unroll
                    for (int j = 0; j < 4; ++j) h[n][j] = g[j] * sigmoidf_(g[j]) * up[j]; }
                *(gu32x4*)(HM + (size_t)row * DFF + cb) = pack8(h[0], h[1]); }
    }
};
}

__device__ __forceinline__ float wave_sum(float v) {
#pragma unroll
    for (int o = 1; o < 64; o <<= 1) v += __shfl_xor(v, o);
    return v;
}
__device__ __forceinline__ void p0a_fold(const float* w_in, const float* mix, const float* scale, float* wut, int gtid, int nthr) {
    for (int o = gtid; o < DEPTH * 1024 * 512; o += nthr) {
        const int n = o & 511, k = (o >> 9) & 1023, l = o >> 19, g = n >> 7, d = n & 127;
        const float* wr = w_in + ((size_t)l * 1024 + k) * NIN + 1536 + g * 128;
        const float* mx = mix + ((size_t)(l * 4 + g) * 128) * 128 + d;
        float s = 0.f;
#pragma unroll 8
        for (int c = 0; c < 128; ++c) s += wr[c] * mx[(size_t)c * 128];
        wut[o] = s * scale[l * 512 + n];
    }
}
__device__ __forceinline__ void tr_item(const float* src, int ld, int c0, const float* gk, int k0, bf16* WT, int K, int drow0, LAS float* scr, int lane) {
    const int kr = lane >> 3, c4 = (lane & 7) * 4;
    f32x4 v[8];
#pragma unroll
    for (int i = 0; i < 8; ++i) v[i] = *(const GAS f32x4*)(src + (size_t)(k0 + 8 * i + kr) * ld + c0 + c4);
#pragma unroll
    for (int i = 0; i < 8; ++i) { const int kk = 8 * i + kr; f32x4 x = v[i]; if (gk) x = x * gk[k0 + kk];
        scr[(c4 + 0) * 68 + kk] = x[0]; scr[(c4 + 1) * 68 + kk] = x[1]; scr[(c4 + 2) * 68 + kk] = x[2]; scr[(c4 + 3) * 68 + kk] = x[3]; }
    LDS_WAIT(); asm volatile("" ::: "memory");
    const int c = lane & 7;
#pragma unroll
    for (int j = 0; j < 4; ++j) { const int n = (lane >> 3) + 8 * j; const LAS f32x4* s4 = (const LAS f32x4*)(scr + n * 68 + 8 * c); const f32x4 a = s4[0], b = s4[1];
        v4u o; o.x = pk2(a[0], a[1]); o.y = pk2(a[2], a[3]); o.z = pk2(b[0], b[1]); o.w = pk2(b[2], b[3]);
        *(GAS v4u*)(WT + (size_t)(drow0 + n) * K + k0 + 8 * c) = o; }
    LDS_WAIT(); asm volatile("" ::: "memory");
}
struct In14 { const float *x, *meta, *g1, *w_in, *b_gate, *mix, *scale, *wbp, *wbs, *wout, *g2, *wf1, *wf2, *gf; };
__device__ __forceinline__ void p0b_weights(const In14& I, unsigned char* ws, LAS float* scr, int gw, int ngw, int lane) {
    constexpr int I_IN = 16 * 128, I_BP = 8 * 32, I_OUT = 16 * 32, I_F1 = 16 * 176, I_F2 = 44 * 32, I_L = I_IN + 2 * I_BP + I_OUT + I_F1 + I_F2;
    for (int it = gw; it < DEPTH * I_L; it += ngw) {
        const int l = it / I_L; int r = it % I_L;
        if (r < I_IN) { const int kb = r >> 7, nb = r & 127, n0 = nb * 32; const bool fold = (n0 >= 1536 && n0 < 2048);
            const float* src = fold ? (const float*)(ws + WS_WUT) + (size_t)l * 1024 * 512 : I.w_in + (size_t)l * 1024 * NIN;
            tr_item(src, fold ? 512 : NIN, fold ? n0 - 1536 : n0, I.g1 + l * 1024, kb * 64, (bf16*)(ws + WS_WIN) + (size_t)l * NIN * 1024, 1024, n0, scr, lane); continue; }
        r -= I_IN;
        if (r < I_BP) { const int kb = r >> 5, nb = r & 31; tr_item(I.wbp + (size_t)l * 512 * 1024, 1024, nb * 32, nullptr, kb * 64, (bf16*)(ws + WS_WBP) + (size_t)l * 1024 * 512, 512, nb * 32, scr, lane); continue; }
        r -= I_BP;
        if (r < I_BP) { const int kb = r >> 5, nb = r & 31; tr_item(I.wbs + (size_t)l * 512 * 1024, 1024, nb * 32, nullptr, kb * 64, (bf16*)(ws + WS_WBS) + (size_t)l * 1024 * 512, 512, nb * 32, scr, lane); continue; }
        r -= I_BP;
        if (r < I_OUT) { const int kb = r >> 5, nb = r & 31; tr_item(I.wout + (size_t)l * 1024 * 1024, 1024, nb * 32, nullptr, kb * 64, (bf16*)(ws + WS_WOUT) + (size_t)l * 1024 * 1024, 1024, nb * 32, scr, lane); continue; }
        r -= I_OUT;
        if (r < I_F1) { const int kb = r / 176, jb = r % 176, j0 = jb * 32, pn = j0 >> 8, jj = j0 & 255; const int c0 = jj < 128 ? pn * 128 + jj : DFF + pn * 128 + (jj - 128);
            tr_item(I.wf1 + (size_t)l * 1024 * NF1, NF1, c0, I.g2 + l * 1024, kb * 64, (bf16*)(ws + WS_WF1) + (size_t)l * NF1 * 1024, 1024, j0, scr, lane); continue; }
        r -= I_F1;
        { const int kb = r >> 5, nb = r & 31; tr_item(I.wf2 + (size_t)l * DFF * 1024, 1024, nb * 32, nullptr, kb * 64, (bf16*)(ws + WS_WF2) + (size_t)l * 1024 * DFF, DFF, nb * 32, scr, lane); }
    }
}
__device__ __forceinline__ void p0b_rows(const In14& I, unsigned char* ws, int gw, int ngw, int lane) {
    for (int r2 = gw; r2 < M_PAD / 2; r2 += ngw) {
        f32x4 v[2][4]; const float* src[2];
#pragma unroll
        for (int h = 0; h < 2; ++h) { const int row = 2 * r2 + h; src[h] = row < M_MAIN ? I.x + (size_t)row * D : (row < M_MAIN + NMETA ? I.meta + (size_t)(row - M_MAIN) * D : nullptr);
#pragma unroll
            for (int j = 0; j < 4; ++j) v[h][j] = src[h] ? ((const GAS f32x4*)src[h])[64 * j + lane] : (f32x4){0.f, 0.f, 0.f, 0.f}; }
#pragma unroll
        for (int h = 0; h < 2; ++h) { const int row = 2 * r2 + h; float s = 0.f;
#pragma unroll
            for (int j = 0; j < 4; ++j) s += (v[h][j].x * v[h][j].x + v[h][j].y * v[h][j].y) + (v[h][j].z * v[h][j].z + v[h][j].w * v[h][j].w);
            s = wave_sum(s);
            GAS unsigned long long* o8 = (GAS unsigned long long*)((bf16*)(ws + WS_XB) + (size_t)row * D) + lane;
#pragma unroll
            for (int j = 0; j < 4; ++j) o8[64 * j] = (unsigned long long)pk2(v[h][j].x, v[h][j].y) | ((unsigned long long)pk2(v[h][j].z, v[h][j].w) << 32);
            if (lane < 16) ((float*)(ws + WS_SSA))[(size_t)(lane >> 2) * (M_PAD * 4) + (size_t)row * 4 + (lane & 3)] = lane == 0 ? s : 0.f;
            if (row >= M_MAIN && row < M_MAIN + NMETA) { GAS f32x4* xm = (GAS f32x4*)((float*)(ws + WS_XM) + (size_t)(row - M_MAIN) * D);
#pragma unroll
                for (int j = 0; j < 4; ++j) xm[64 * j + lane] = v[h][j]; } }
    }
}
__device__ __forceinline__ float bf_lo(unsigned w) { return __uint_as_float(w << 16); }
__device__ __forceinline__ float bf_hi(unsigned w) { return __uint_as_float(w & 0xffff0000u); }
template <int WIN>
__device__ __forceinline__ void pool_item(const bf16* U, bf16* A, int i, int c8) {
    int b, p; if (i < M_MAIN) { b = i >> 11; p = NMETA + (i & 2047); } else { b = 0; p = i - M_MAIN; }
    const bf16* up = U + (size_t)(b * LTOT + p) * 512 + c8 * 8;
    v4u v[WIN];
#pragma unroll
    for (int j = 0; j < WIN; ++j) v[j] = *(const GAS v4u*)(up - (size_t)(j <= p ? j : p) * 512);
    float a[8];
#pragma unroll
    for (int e = 0; e < 8; ++e) a[e] = 0.f;
#pragma unroll
    for (int j = 0; j < WIN; ++j) { const float wj = (j <= p) ? 1.0f : 0.0f;
        a[0] += wj * bf_lo(v[j].x); a[1] += wj * bf_hi(v[j].x); a[2] += wj * bf_lo(v[j].y); a[3] += wj * bf_hi(v[j].y); a[4] += wj * bf_lo(v[j].z); a[5] += wj * bf_hi(v[j].z); a[6] += wj * bf_lo(v[j].w); a[7] += wj * bf_hi(v[j].w); }
    const int cnt = (p + 1 < WIN) ? p + 1 : WIN; const float inv = 1.0f / (float)cnt;
    v4u o; o.x = pk2(a[0] * inv - bf_lo(v[0].x), a[1] * inv - bf_hi(v[0].x)); o.y = pk2(a[2] * inv - bf_lo(v[0].y), a[3] * inv - bf_hi(v[0].y));
    o.z = pk2(a[4] * inv - bf_lo(v[0].z), a[5] * inv - bf_hi(v[0].z)); o.w = pk2(a[6] * inv - bf_lo(v[0].w), a[7] * inv - bf_hi(v[0].w));
    *(GAS v4u*)(A + (size_t)i * 512 + c8 * 8) = o;
}
__device__ __forceinline__ void pool_filter(const bf16* U, bf16* A, int gw, int ngw, int lane, int nrows) {
    for (int it = gw; it < (nrows / 4) * 4; it += ngw) {
        const int g = it & 3, i = (it >> 2) * 4 + (lane >> 4), c8 = g * 16 + (lane & 15);
        if (g == 0) pool_item<2>(U, A, i, c8); else if (g == 1) pool_item<4>(U, A, i, c8); else if (g == 2) pool_item<8>(U, A, i, c8); else pool_item<16>(U, A, i, c8);
    }
}
template <bool META_ONLY> __device__ __forceinline__ void attn_simple(const bf16* Q, const bf16* K, const bf16* V, bf16* S, int gw, int ngw, int lane) {
    for (int it = META_ONLY ? NB * NH * (SEQ / 64) + gw : gw; it < NB * NH * (SEQ / 64) + NH; it += ngw) {
        int b, h, p, qrow, smax;
        if (it < NB * NH * (SEQ / 64)) { const int bh = it >> 5, qc = it & 31; b = bh >> 3; h = bh & 7; const int t = qc * 64 + lane; p = NMETA + t; qrow = b * SEQ + t; smax = NMETA + qc * 64 + 63; }
        else { h = it - NB * NH * (SEQ / 64); b = 0; p = lane < NMETA ? lane : 0; qrow = M_MAIN + (lane < NMETA ? lane : 0); smax = NMETA; }
        float q[64], o[64];
        { const GAS v4u* qp = (const GAS v4u*)(Q + (size_t)qrow * 512 + h * 64);
#pragma unroll
          for (int c = 0; c < 8; ++c) { const v4u v = qp[c]; q[8 * c + 0] = bf_lo(v.x); q[8 * c + 1] = bf_hi(v.x); q[8 * c + 2] = bf_lo(v.y); q[8 * c + 3] = bf_hi(v.y); q[8 * c + 4] = bf_lo(v.z); q[8 * c + 5] = bf_hi(v.z); q[8 * c + 6] = bf_lo(v.w); q[8 * c + 7] = bf_hi(v.w); } }
#pragma unroll
        for (int d = 0; d < 64; ++d) o[d] = 0.f;
        float I = 1.0f;
        for (int s = smax - 1; s >= 0; --s) {
#if EARLY_EXIT
            if (!__any(I != 0.0f)) break;
#endif
            int soff = (b * LTOT + s) * 512 + h * 64; asm volatile("" : "+v"(soff));
            const GAS v4u* kp = (const GAS v4u*)(K + soff); const GAS v4u* vp = (const GAS v4u*)(V + soff);
            float z = 0.f;
#pragma unroll
            for (int c = 0; c < 8; ++c) { const v4u v = kp[c];
                z += q[8 * c + 0] * bf_lo(v.x) + q[8 * c + 1] * bf_hi(v.x) + q[8 * c + 2] * bf_lo(v.y) + q[8 * c + 3] * bf_hi(v.y) + q[8 * c + 4] * bf_lo(v.z) + q[8 * c + 5] * bf_hi(v.z) + q[8 * c + 6] * bf_lo(v.w) + q[8 * c + 7] * bf_hi(v.w); }
            float m = __builtin_amdgcn_rcpf(1.0f + __builtin_amdgcn_exp2f(z));
            if (s >= p) m = 1.0f;
            const float In = I * m, w = I - In; I = In;
#pragma unroll
            for (int c = 0; c < 8; ++c) { const v4u v = vp[c];
                o[8 * c + 0] += w * bf_lo(v.x); o[8 * c + 1] += w * bf_hi(v.x); o[8 * c + 2] += w * bf_lo(v.y); o[8 * c + 3] += w * bf_hi(v.y); o[8 * c + 4] += w * bf_lo(v.z); o[8 * c + 5] += w * bf_hi(v.z); o[8 * c + 6] += w * bf_lo(v.w); o[8 * c + 7] += w * bf_hi(v.w); }
        }
        if (it < NB * NH * (SEQ / 64) || lane < NMETA) { GAS v4u* sp = (GAS v4u*)(S + (size_t)qrow * 512 + h * 64);
#pragma unroll
            for (int c = 0; c < 8; ++c) { v4u w; w.x = pk2(o[8 * c + 0], o[8 * c + 1]); w.y = pk2(o[8 * c + 2], o[8 * c + 3]); w.z = pk2(o[8 * c + 4], o[8 * c + 5]); w.w = pk2(o[8 * c + 6], o[8 * c + 7]); sp[c] = w; } }
    }
}
namespace sba {
typedef short bf16x8 __attribute__((ext_vector_type(8)));
typedef float f32x16 __attribute__((ext_vector_type(16)));
typedef short v4i16_t __attribute__((ext_vector_type(4)));
typedef float f32x2_t __attribute__((ext_vector_type(2))); typedef __bf16 bf16x2_t __attribute__((ext_vector_type(2)));
__device__ __forceinline__ unsigned cvtpk(float lo, float hi) { f32x2_t v = {lo, hi}; bf16x2_t b = __builtin_convertvector(v, bf16x2_t); return __builtin_bit_cast(unsigned, b); }
__device__ __forceinline__ int crow(int r, int hi) { return (r & 3) + 8 * (r >> 2) + 4 * hi; }
__device__ __forceinline__ bf16x8 vfrag(LAS const unsigned char* p) {
    const v4i16_t lo = __builtin_amdgcn_ds_read_tr16_b64_v4i16((LAS v4i16_t*)p), hi = __builtin_amdgcn_ds_read_tr16_b64_v4i16((LAS v4i16_t*)(p + 8 * 128));
    return (bf16x8){lo[0], lo[1], lo[2], lo[3], hi[0], hi[1], hi[2], hi[3]};
}
#define SBA_BLOCK(x0, x1, x2, x3, Sv) do { const float P3_ = x3 * (Sv), P2_ = x2 * (Sv), P1_ = x1 * (Sv), P0_ = x0 * (Sv); x3 = (Sv) - P3_; x2 = P3_ - P2_; x1 = P2_ - P1_; x0 = P1_ - P0_; } while (0)
__device__ __forceinline__ void unit(const bf16* Q, const bf16* K, const bf16* V, bf16* S, int b, int h, int qi, LAS unsigned char* vl, int lane) {
    const int ql = lane & 31, hi = lane >> 5;
    const int t0 = 32 * qi, qrow = b * SEQ + t0 + ql, kend = NMETA + t0 + 32;
    bf16x8 qf[4];
    { const GAS bf16x8* qp = (const GAS bf16x8*)(Q + (size_t)qrow * 512 + h * 64 + 8 * hi);
#pragma unroll
      for (int ks = 0; ks < 4; ++ks) qf[ks] = qp[2 * ks]; }
    f32x16 o0, o1;
#pragma unroll
    for (int r = 0; r < 16; ++r) { o0[r] = 0.f; o1[r] = 0.f; }
    float R = 1.0f;
    const bf16* Kb = K + (size_t)b * LTOT * 512 + h * 64; const bf16* Vb = V + (size_t)b * LTOT * 512 + h * 64;
    const int g4 = lane >> 4, i16 = lane & 15;
    LAS const unsigned char* vrd = vl + (4 * hi + (i16 >> 2)) * 128 + (16 * (g4 & 1) + 4 * (i16 & 3)) * 2;
    for (int ts = kend - 64;; ts -= 64) {
        bf16x8 kf[2][4];
#pragma unroll
        for (int blk = 0; blk < 2; ++blk) { int row = ts + 32 * blk + ql; row = row < 0 ? 0 : row;
            const GAS bf16x8* kp = (const GAS bf16x8*)(Kb + (size_t)row * 512 + 8 * hi);
#pragma unroll
            for (int ks = 0; ks < 4; ++ks) kf[blk][ks] = kp[2 * ks]; }
        { int row = ts + lane; row = row < 0 ? 0 : row; const GAS v4u* vp = (const GAS v4u*)(Vb + (size_t)row * 512);
#pragma unroll
          for (int c = 0; c < 8; ++c) { const int ch = (c + lane) & 7; const v4u v = vp[ch]; *(LAS v4u*)(vl + lane * 128 + ch * 16) = v; } }
        f32x16 p0, p1;
#pragma unroll
        for (int r = 0; r < 16; ++r) { p0[r] = 0.f; p1[r] = 0.f; }
#pragma unroll
        for (int ks = 0; ks < 4; ++ks) { p0 = __builtin_amdgcn_mfma_f32_32x32x16_bf16(kf[0][ks], qf[ks], p0, 0, 0, 0); p1 = __builtin_amdgcn_mfma_f32_32x32x16_bf16(kf[1][ks], qf[ks], p1, 0, 0, 0); }
#pragma unroll
        for (int r = 0; r < 16; ++r) { p0[r] = __builtin_amdgcn_rcpf(1.0f + __builtin_amdgcn_exp2f(p0[r])); p1[r] = __builtin_amdgcn_rcpf(1.0f + __builtin_amdgcn_exp2f(p1[r])); }
        if (ts == kend - 64) {
#pragma unroll
            for (int r = 0; r < 16; ++r) if (crow(r, hi) >= ql) p1[r] = 1.0f;
        }
        if (ts < 0) {
#pragma unroll
            for (int r = 0; r < 16; ++r) { if (crow(r, hi) < -ts) p0[r] = 1.0f; if (32 + crow(r, hi) < -ts) p1[r] = 1.0f; }
        }
        float U[8], Pn[8];
#pragma unroll
        for (int g = 0; g < 4; ++g) { p0[4 * g + 2] *= p0[4 * g + 3]; p0[4 * g + 1] *= p0[4 * g + 2]; p0[4 * g] *= p0[4 * g + 1];
                                      p1[4 * g + 2] *= p1[4 * g + 3]; p1[4 * g + 1] *= p1[4 * g + 2]; p1[4 * g] *= p1[4 * g + 1]; }
#pragma unroll
        for (int g = 0; g < 8; ++g) { const float T = g < 4 ? p0[4 * g] : p1[4 * (g - 4)];
            const auto rr = __builtin_amdgcn_permlane32_swap(__float_as_uint(T), __float_as_uint(T), false, false);
            const float a = __uint_as_float(rr[0]), c = __uint_as_float(rr[1]);
            U[g] = a * c;
            Pn[g] = hi ? 1.0f : c;
        }
        float E = R;
#pragma unroll
        for (int g = 7; g >= 0; --g) { const float Sg = E * Pn[g]; E *= U[g];
            if (g < 4) SBA_BLOCK(p0[4 * g], p0[4 * g + 1], p0[4 * g + 2], p0[4 * g + 3], Sg);
            else SBA_BLOCK(p1[4 * (g - 4)], p1[4 * (g - 4) + 1], p1[4 * (g - 4) + 2], p1[4 * (g - 4) + 3], Sg); }
        R = E;
        bf16x8 wf[2][2];
#pragma unroll
        for (int s2 = 0; s2 < 2; ++s2) {
            const v4u a = {cvtpk(p0[8 * s2], p0[8 * s2 + 1]), cvtpk(p0[8 * s2 + 2], p0[8 * s2 + 3]), cvtpk(p0[8 * s2 + 4], p0[8 * s2 + 5]), cvtpk(p0[8 * s2 + 6], p0[8 * s2 + 7])};
            const v4u c = {cvtpk(p1[8 * s2], p1[8 * s2 + 1]), cvtpk(p1[8 * s2 + 2], p1[8 * s2 + 3]), cvtpk(p1[8 * s2 + 4], p1[8 * s2 + 5]), cvtpk(p1[8 * s2 + 6], p1[8 * s2 + 7])};
            wf[0][s2] = __builtin_bit_cast(bf16x8, a); wf[1][s2] = __builtin_bit_cast(bf16x8, c); }
#pragma unroll
        for (int blk = 0; blk < 2; ++blk)
#pragma unroll
            for (int s2 = 0; s2 < 2; ++s2) { LAS const unsigned char* vp = vrd + (32 * blk + 16 * s2) * 128;
                o0 = __builtin_amdgcn_mfma_f32_32x32x16_bf16(vfrag(vp), wf[blk][s2], o0, 0, 0, 0);
                o1 = __builtin_amdgcn_mfma_f32_32x32x16_bf16(vfrag(vp + 64), wf[blk][s2], o1, 0, 0, 0); }
        if (ts <= 0) break;
#if EARLY_EXIT
        if (!__any(R != 0.0f)) break;
#endif
    }
    GAS unsigned long long* sp = (GAS unsigned long long*)(S + (size_t)qrow * 512 + h * 64 + 4 * hi);
#pragma unroll
    for (int g = 0; g < 4; ++g) {
        sp[2 * g] = (unsigned long long)cvtpk(o0[4 * g], o0[4 * g + 1]) | ((unsigned long long)cvtpk(o0[4 * g + 2], o0[4 * g + 3]) << 32);
        sp[8 + 2 * g] = (unsigned long long)cvtpk(o1[4 * g], o1[4 * g + 1]) | ((unsigned long long)cvtpk(o1[4 * g + 2], o1[4 * g + 3]) << 32); }
}
#undef SBA_BLOCK
__device__ __forceinline__ void phase(const bf16* Q, const bf16* K, const bf16* V, bf16* S, LAS unsigned char* lds, int gw, int ngw, int wave, int lane) {
    LAS unsigned char* vl = lds + wave * 8192;
    for (int w = gw; w < NB * NH * 32; w += ngw) { const int bh = w >> 5, j = w & 31;
#pragma unroll 1
        for (int rep = 0; rep < 2; ++rep) unit(Q, K, V, S, bh >> 3, bh & 7, rep ? 63 - j : j, vl, lane); }
}
}
namespace meta {
typedef short bf16x8 __attribute__((ext_vector_type(8)));
typedef float f32x4 __attribute__((ext_vector_type(4)));
typedef GAS unsigned short gbf;
__device__ __forceinline__ float bfv(short h) { return __uint_as_float((unsigned)(unsigned short)h << 16); }
__device__ __forceinline__ float sigm(float x) { return __builtin_amdgcn_rcpf(1.0f + __builtin_amdgcn_exp2f(-LOG2E * x)); }
template <int NIT, bool SUMSQ>
__device__ __forceinline__ void partial(const bf16* A, const bf16* B, int K, int kb, int lane, f32x4& acc, float& q) {
    const int r = lane & 15, kq = lane >> 4;
    const GAS bf16x8* a0 = (const GAS bf16x8*)(A + (size_t)r * K + kb + 8 * kq); const GAS bf16x8* b0 = (const GAS bf16x8*)(B + (size_t)r * K + kb + 8 * kq);
    bf16x8 a[NIT], b[NIT];
#pragma unroll
    for (int it = 0; it < NIT; ++it) { a[it] = a0[4 * it]; b[it] = b0[4 * it]; }
#pragma unroll
    for (int it = 0; it < NIT; ++it) { acc = __builtin_amdgcn_mfma_f32_16x16x32_bf16(a[it], b[it], acc, 0, 0, 0);
        if (SUMSQ) {
#pragma unroll
            for (int j = 0; j < 8; ++j) { const float v = bfv(a[it][j]); q += v * v; } } }
}
__device__ __forceinline__ void reduce8(LAS float* red, int wave, int lane, f32x4& acc0, f32x4& acc1, float& q) {
    *(LAS f32x4*)(red + (wave * 2 + 0) * 256 + lane * 4) = acc0; *(LAS f32x4*)(red + (wave * 2 + 1) * 256 + lane * 4) = acc1; red[4096 + wave * 64 + lane] = q;
    __syncthreads();
    if (wave == 0) { f32x4 s0 = {0.f, 0.f, 0.f, 0.f}, s1 = {0.f, 0.f, 0.f, 0.f}; float sq = 0.f;
#pragma unroll
        for (int w = 0; w < 8; ++w) { s0 += *(LAS f32x4*)(red + (w * 2 + 0) * 256 + lane * 4); s1 += *(LAS f32x4*)(red + (w * 2 + 1) * 256 + lane * 4); sq += red[4096 + w * 64 + lane]; }
        sq += __shfl_xor(sq, 16); sq += __shfl_xor(sq, 32);
        acc0 = s0; acc1 = s1; q = sq; }
}
struct Ptrs { unsigned char* ws; const float* bias; int l; const bf16* Ab; const bf16* Sb; };
__device__ __forceinline__ void in_proj(const Ptrs& P, LAS float* red, int bx, int wave, int lane) {
    const int s = 255 - bx, n0 = s * 16; if (s < 0 || s >= 256) return;
    const bf16* A = (const bf16*)(P.ws + WS_XB) + (size_t)M_MAIN * 1024; const bf16* B = (const bf16*)(P.ws + WS_WIN) + (size_t)P.l * NIN * 1024 + (size_t)n0 * 1024;
    f32x4 acc = {0.f, 0.f, 0.f, 0.f}, z = {0.f, 0.f, 0.f, 0.f}; float ssq = 0.f;
    partial<4, true>(A, B, 1024, wave * 128, lane, acc, ssq);
    reduce8(red, wave, lane, acc, z, ssq);
    if (wave == 0) {
        const float rsr = __builtin_amdgcn_rsqf(ssq * (1.0f / 1024.0f) + RMS_EPS);
        const int n = n0 + (lane & 15), r0 = 4 * (lane >> 4);
#pragma unroll
        for (int i = 0; i < 4; ++i) { const int row = r0 + i; const float rs = __shfl(rsr, row); const float v = acc[i] * rs;
            if (n < 512) ((gbf*)(P.ws + WS_Q))[(size_t)(M_MAIN + row) * 512 + n] = (unsigned short)f2bf(v * QSCALE);
            else if (n < 2048) { const int t = (n >> 9) % 3; gbf* base = (gbf*)(P.ws + WS_U + (size_t)t * ACT16); const unsigned short hv = (unsigned short)f2bf(v);
#pragma unroll
                for (int b2 = 0; b2 < NB; ++b2) base[(size_t)(b2 * LTOT + row) * 512 + (n & 511)] = hv; }
            else ((gbf*)(P.ws + WS_G))[(size_t)(M_MAIN + row) * 2048 + (n - 2048)] = (unsigned short)f2bf(sigm(v + P.bias[n - 2048])); }
    }
    __syncthreads();
}
__device__ __forceinline__ void branches(const Ptrs& P, LAS float* red, int bx, int wave, int lane) {
    const int s = 255 - bx, n0 = s * 16; if (s < 0 || s >= 64) return;
    const bool second = wave >= 4;
    const bf16* A = (second ? P.Sb : P.Ab) + (size_t)M_MAIN * 512;
    const bf16* B = (const bf16*)(P.ws + (second ? WS_WBS : WS_WBP)) + (size_t)P.l * 1024 * 512 + (size_t)n0 * 512;
    f32x4 acc = {0.f, 0.f, 0.f, 0.f}, z = {0.f, 0.f, 0.f, 0.f}; float ssq = 0.f;
    partial<4, false>(A, B, 512, (wave & 3) * 128, lane, acc, ssq);
    f32x4 ap = second ? z : acc, as = second ? acc : z;
    reduce8(red, wave, lane, ap, as, ssq);
    if (wave == 0) {
        const int n = n0 + (lane & 15), r0 = 4 * (lane >> 4); const gbf* G = (const gbf*)(P.ws + WS_G);
#pragma unroll
        for (int i = 0; i < 4; ++i) { const size_t row = M_MAIN + r0 + i; const float gp = bfv((short)G[row * 2048 + n]), gs = bfv((short)G[row * 2048 + 1024 + n]);
            ((gbf*)(P.ws + WS_MG))[row * 1024 + n] = (unsigned short)f2bf(gp * ap[i] + gs * as[i]); }
    }
    __syncthreads();
}
template <int NIT>
__device__ __forceinline__ void residual(const Ptrs& P, const bf16* A, const bf16* Bt, LAS float* red, int bx, int wave, int lane) {
    constexpr int K = NIT * 256;
    const int s = 255 - bx, n0 = s * 16; if (s < 0 || s >= 64) return;
    f32x4 acc = {0.f, 0.f, 0.f, 0.f}, z = {0.f, 0.f, 0.f, 0.f}; float ssq = 0.f;
    partial<NIT, false>(A, Bt + (size_t)n0 * K, K, wave * (NIT * 32), lane, acc, ssq);
    reduce8(red, wave, lane, acc, z, ssq);
    if (wave == 0) {
        const int n = n0 + (lane & 15), r0 = 4 * (lane >> 4); GAS float* xm = (GAS float*)(P.ws + WS_XM);
#pragma unroll
        for (int i = 0; i < 4; ++i) { const int row = r0 + i; const float v = xm[(size_t)row * 1024 + n] + acc[i]; xm[(size_t)row * 1024 + n] = v;
            ((gbf*)(P.ws + WS_XB))[(size_t)(M_MAIN + row) * 1024 + n] = (unsigned short)f2bf(v); }
    }
    __syncthreads();
}
__device__ __forceinline__ void ffn_in(const Ptrs& P, LAS float* red, int bx, int wave, int lane) {
    const int s = 255 - bx, c0 = s * 16, pn = c0 >> 7, jj = c0 & 127; if (s < 0 || s >= 176) return;
    const bf16* A = (const bf16*)(P.ws + WS_XB) + (size_t)M_MAIN * 1024; const bf16* Bg = (const bf16*)(P.ws + WS_WF1) + (size_t)P.l * NF1 * 1024 + (size_t)(pn * 256 + jj) * 1024;
    f32x4 ag = {0.f, 0.f, 0.f, 0.f}, au = {0.f, 0.f, 0.f, 0.f}; float ssq = 0.f, dq = 0.f;
    partial<4, true>(A, Bg, 1024, wave * 128, lane, ag, ssq);
    partial<4, false>(A, Bg + (size_t)128 * 1024, 1024, wave * 128, lane, au, dq);
    reduce8(red, wave, lane, ag, au, ssq);
    if (wave == 0) {
        const float rsr = __builtin_amdgcn_rsqf(ssq * (1.0f / 1024.0f) + RMS_EPS);
        const int c = c0 + (lane & 15), r0 = 4 * (lane >> 4);
#pragma unroll
        for (int i = 0; i < 4; ++i) { const int row = r0 + i; const float rs = __shfl(rsr, row); const float g = ag[i] * rs, u = au[i] * rs;
            ((gbf*)(P.ws + WS_HM))[(size_t)(M_MAIN + row) * DFF + c] = (unsigned short)f2bf(g * sigm(g) * u); }
    }
    __syncthreads();
}
}

__device__ __forceinline__ void attn_meta(const bf16* Q, const bf16* K, const bf16* V, bf16* S, int h, int lane) {
    const int q = lane & 15, dq = lane >> 4;
    float qv[16];
    { const GAS v4u* qp = (const GAS v4u*)(Q + (size_t)(M_MAIN + q) * 512 + h * 64 + dq * 16);
#pragma unroll
      for (int c = 0; c < 2; ++c) { const v4u v = qp[c]; qv[8 * c + 0] = bf_lo(v.x); qv[8 * c + 1] = bf_hi(v.x); qv[8 * c + 2] = bf_lo(v.y); qv[8 * c + 3] = bf_hi(v.y); qv[8 * c + 4] = bf_lo(v.z); qv[8 * c + 5] = bf_hi(v.z); qv[8 * c + 6] = bf_lo(v.w); qv[8 * c + 7] = bf_hi(v.w); } }
    v4u kv[NMETA][2];
#pragma unroll
    for (int s2 = 0; s2 < NMETA; ++s2) { const GAS v4u* kp = (const GAS v4u*)(K + (size_t)s2 * 512 + h * 64 + dq * 16); kv[s2][0] = kp[0]; kv[s2][1] = kp[1]; }
    float z[NMETA];
#pragma unroll
    for (int s2 = 0; s2 < NMETA; ++s2) { float t = 0.f;
#pragma unroll
        for (int c = 0; c < 2; ++c) { const v4u v = kv[s2][c];
            t += qv[8 * c + 0] * bf_lo(v.x) + qv[8 * c + 1] * bf_hi(v.x) + qv[8 * c + 2] * bf_lo(v.y) + qv[8 * c + 3] * bf_hi(v.y) + qv[8 * c + 4] * bf_lo(v.z) + qv[8 * c + 5] * bf_hi(v.z) + qv[8 * c + 6] * bf_lo(v.w) + qv[8 * c + 7] * bf_hi(v.w); }
        t += __shfl_xor(t, 16); t += __shfl_xor(t, 32); z[s2] = t; }
#pragma unroll
    for (int s2 = 0; s2 < NMETA; ++s2) { const GAS v4u* vp = (const GAS v4u*)(V + (size_t)s2 * 512 + h * 64 + dq * 16); kv[s2][0] = vp[0]; kv[s2][1] = vp[1]; }
    float o[16], I = 1.0f;
#pragma unroll
    for (int d = 0; d < 16; ++d) o[d] = 0.f;
#pragma unroll
    for (int s2 = NMETA - 1; s2 >= 0; --s2) { float m = __builtin_amdgcn_rcpf(1.0f + __builtin_amdgcn_exp2f(z[s2])); if (s2 >= q) m = 1.0f;
        const float In = I * m, w = I - In; I = In;
#pragma unroll
        for (int c = 0; c < 2; ++c) { const v4u v = kv[s2][c];
            o[8 * c + 0] += w * bf_lo(v.x); o[8 * c + 1] += w * bf_hi(v.x); o[8 * c + 2] += w * bf_lo(v.y); o[8 * c + 3] += w * bf_hi(v.y); o[8 * c + 4] += w * bf_lo(v.z); o[8 * c + 5] += w * bf_hi(v.z); o[8 * c + 6] += w * bf_lo(v.w); o[8 * c + 7] += w * bf_hi(v.w); } }
    GAS v4u* sp = (GAS v4u*)(S + (size_t)(M_MAIN + q) * 512 + h * 64 + dq * 16);
#pragma unroll
    for (int c = 0; c < 2; ++c) { v4u w; w.x = pk2(o[8 * c + 0], o[8 * c + 1]); w.y = pk2(o[8 * c + 2], o[8 * c + 3]); w.z = pk2(o[8 * c + 4], o[8 * c + 5]); w.w = pk2(o[8 * c + 6], o[8 * c + 7]); sp[c] = w; }
}
__device__ __forceinline__ void final_norm(float* out, const float* gf, int gw, int ngw, int lane) {
    f32x4 g[4];
#pragma unroll
    for (int j = 0; j < 4; ++j) g[j] = ((const GAS f32x4*)gf)[64 * j + lane];
    for (int row = gw; row < M_MAIN; row += ngw) {
        GAS f32x4* xr = (GAS f32x4*)(out + (size_t)row * D); f32x4 v[4]; float s = 0.f;
#pragma unroll
        for (int j = 0; j < 4; ++j) { v[j] = xr[64 * j + lane]; s += (v[j].x * v[j].x + v[j].y * v[j].y) + (v[j].z * v[j].z + v[j].w * v[j].w); }
        const float rs = 1.0f / sqrtf(wave_sum(s) * (1.0f / D) + RMS_EPS);
#pragma unroll
        for (int j = 0; j < 4; ++j) xr[64 * j + lane] = v[j] * rs * g[j];
    }
}

constexpr int N_PHASES = 15;
struct Args { const float* in[14]; float* out; unsigned char* ws; int ph_lo, ph_hi; };
__global__ void __launch_bounds__(NWAVES * 64, 2) fwd_kernel(Args args) {
    extern __shared__ __attribute__((aligned(16))) unsigned char lds[];
    LAS unsigned char* L = (LAS unsigned char*)lds;
    volatile LAS unsigned* MISC = (volatile LAS unsigned*)(L + MISC_OFF);
    const int G = gridDim.x, bx = blockIdx.x, vcu = (G % 8 == 0) ? (bx % 8) * (G / 8) + bx / 8 : bx;
    const int ngw = G * NWAVES, nthr = G * NWAVES * 64;
#define LANE_VARS int tid = threadIdx.x; asm volatile("" : "+v"(tid)); const int lane = tid & 63, wave = __builtin_amdgcn_readfirstlane(tid >> 6), gw = vcu * NWAVES + wave, gtid = bx * (NWAVES * 64) + tid; (void)lane; (void)gw; (void)gtid;
    unsigned char* ws = args.ws;
    gu32* ctl = (gu32*)(ws + WS_CTL);
    In14 I; I.x = args.in[0]; I.meta = args.in[1]; I.g1 = args.in[2]; I.w_in = args.in[3]; I.b_gate = args.in[4]; I.mix = args.in[5]; I.scale = args.in[6];
    I.wbp = args.in[7]; I.wbs = args.in[8]; I.wout = args.in[9]; I.g2 = args.in[10]; I.wf1 = args.in[11]; I.wf2 = args.in[12]; I.gf = args.in[13];
    float* out = args.out;
    for (int u = threadIdx.x; u < (LDS_BYTES - LDSCTL_OFF) / 4; u += NWAVES * 64) ((LAS unsigned*)(L + LDSCTL_OFF))[u] = 0u;
    __syncthreads();
    const int lo = args.ph_lo, hi = args.ph_hi;
    const bool multi = (hi - lo) > 1;
    XcdBarrier bar; bar.bar = (unsigned*)(ctl + CW_BAR); bar.x = 0; bar.st = nullptr;
    if (multi) bar = xcd_barrier_post((unsigned*)(ctl + CW_BAR), MISC + 8);
#define IN(k) (lo <= (k) && (k) < hi)
#define SEAM(k) do { if (IN(k) && IN((k) + 1)) xcd_barrier(bar); } while (0)
    if (IN(0)) { LANE_VARS p0a_fold(I.w_in, I.mix, I.scale, (float*)(ws + WS_WUT), gtid, nthr); }
    SEAM(0);
    if (IN(1)) { LANE_VARS p0b_weights(I, ws, (LAS float*)(L + RING_OFF + wave * 16384), gw, ngw, lane); p0b_rows(I, ws, gw, ngw, lane); }
    SEAM(1);
    for (int l = 0; l < DEPTH; ++l) {
        const int pb = 2 + 6 * l;
        unsigned char* w = ws; int bxl = bx, Gl = G; asm volatile("" : "+s"(w), "+s"(bxl), "+s"(Gl));
#define WB(off) ((bf16*)(w + (off)))
        bf16* const Abuf = (bf16*)out; bf16* const Sbuf = (bf16*)((unsigned char*)out + ACT16);
#define WG(off) ((GAS bf16*)(w + (off)))
#define WF(off) ((GAS float*)(w + (off)))
        if (IN(pb + 0)) {
            { LANE_VARS meta::Ptrs MP{w, I.b_gate + l * 2048, l, Abuf, Sbuf}; meta::in_proj(MP, (LAS float*)(L + RING_OFF), bxl, wave, lane); }
            pg8::Gemm g{WB(WS_XB), WB(WS_WIN) + (size_t)l * NIN * 1024, M_PAD, NIN, 1024}; pg8::StaticOrder S; S.init(M_MAIN, NIN, Gl, bxl);
            epi::EpiIn E{WG(WS_Q), WG(WS_U), WG(WS_G), WF(WS_SSA), (const GAS float*)(I.b_gate + l * 2048)};
            pg8::gemm_phase<epi::EpiIn, pg8::StaticOrder, PG8_ALIGN, PG8_SP2>(L + RING_OFF, g, S, E);
        }
        SEAM(pb + 0);
        if (IN(pb + 1)) { LANE_VARS pool_filter(WB(WS_U), Abuf, gw, ngw, lane, l == 0 ? M_MAIN + NMETA : M_MAIN); sba::phase(WB(WS_Q), WB(WS_K), WB(WS_V), Sbuf, L + RING_OFF, gw, ngw, wave, lane);
              if (l == 0 && gw >= ngw - NH) attn_meta(WB(WS_Q), WB(WS_K), WB(WS_V), Sbuf, ngw - 1 - gw, lane); }
        SEAM(pb + 1);
        if (IN(pb + 2)) {
            if (l == 0) { LANE_VARS meta::Ptrs MP{w, nullptr, l, Abuf, Sbuf}; meta::branches(MP, (LAS float*)(L + RING_OFF), bxl, wave, lane); }
            { pg8::Gemm g{Abuf, WB(WS_WBP) + (size_t)l * 1024 * 512, M_PAD, 1024, 512}; pg8::StaticOrder S; S.init(M_MAIN, 1024, Gl, bxl);
              epi::EpiBrA E{WG(WS_G), WG(WS_MP)}; pg8::gemm_phase<epi::EpiBrA, pg8::StaticOrder, PG8_ALIGN, PG8_SP2>(L + RING_OFF, g, S, E); }
            { pg8::Gemm g{Sbuf, WB(WS_WBS) + (size_t)l * 1024 * 512, M_PAD, 1024, 512}; pg8::StaticOrder S; S.init(M_MAIN, 1024, Gl, bxl);
              epi::EpiBrB E{WG(WS_G), WG(WS_MP), WG(WS_MG)}; pg8::gemm_phase<epi::EpiBrB, pg8::StaticOrder, PG8_ALIGN, PG8_SP2>(L + RING_OFF, g, S, E); }
        }
        SEAM(pb + 2);
        if (IN(pb + 3)) {
            if (l == 0) { LANE_VARS meta::Ptrs MP{w, nullptr, l, Abuf, Sbuf}; meta::residual<4>(MP, WB(WS_MG) + (size_t)M_MAIN * 1024, WB(WS_WOUT) + (size_t)l * 1024 * 1024, (LAS float*)(L + RING_OFF), bxl, wave, lane); }
            pg8::Gemm g{WB(WS_MG), WB(WS_WOUT) + (size_t)l * 1024 * 1024, M_PAD, 1024, 1024}; pg8::StaticOrder S; S.init(M_MAIN, 1024, Gl, bxl);
            epi::EpiRes<false> E{WG(WS_XB), WF(WS_SSB), nullptr};
            pg8::gemm_phase<epi::EpiRes<false>, pg8::StaticOrder, PG8_ALIGN, PG8_SP2>(L + RING_OFF, g, S, E);
        }
        SEAM(pb + 3);
        if (IN(pb + 4)) {
            if (l == 0) { LANE_VARS meta::Ptrs MP{w, nullptr, l, Abuf, Sbuf}; meta::ffn_in(MP, (LAS float*)(L + RING_OFF), bxl, wave, lane); }
            pg8::Gemm g{WB(WS_XB), WB(WS_WF1) + (size_t)l * NF1 * 1024, M_PAD, NF1, 1024}; pg8::StaticOrder S; S.init(M_MAIN, NF1, Gl, bxl);
            epi::EpiFfn E{WF(WS_SSB), WG(WS_HM)};
            pg8::gemm_phase<epi::EpiFfn, pg8::StaticOrder, PG8_ALIGN, PG8_SP2>(L + RING_OFF, g, S, E);
        }
        SEAM(pb + 4);
        if (IN(pb + 5)) {
            if (l == 0) { LANE_VARS meta::Ptrs MP{w, nullptr, l, Abuf, Sbuf}; meta::residual<11>(MP, WB(WS_HM) + (size_t)M_MAIN * DFF, WB(WS_WF2) + (size_t)l * 1024 * DFF, (LAS float*)(L + RING_OFF), bxl, wave, lane); }
            pg8::Gemm g{WB(WS_HM), WB(WS_WF2) + (size_t)l * 1024 * DFF, M_PAD, 1024, DFF}; pg8::StaticOrder S; S.init(M_MAIN, 1024, Gl, bxl);
            if (l + 1 < DEPTH) { epi::EpiRes<false> E{WG(WS_XB), WF(WS_SSA), nullptr}; pg8::gemm_phase<epi::EpiRes<false>, pg8::StaticOrder, PG8_ALIGN, PG8_SP2>(L + RING_OFF, g, S, E); }
            else { epi::EpiRes<true> E{WG(WS_XB), nullptr, (GAS float*)out}; pg8::gemm_phase<epi::EpiRes<true>, pg8::StaticOrder, PG8_ALIGN, PG8_SP2>(L + RING_OFF, g, S, E); }
        }
        SEAM(pb + 5);
#undef WB
#undef WG
#undef WF
    }
    if (IN(14)) { LANE_VARS final_norm(out, I.gf, gw, ngw, lane); }
#undef LANE_VARS
#undef IN
#undef SEAM
}

#if defined(DUMP_AFTER)
#ifndef DUMP_LIST
#define DUMP_LIST {WS_G, (size_t)M_PAD * 2048}, {WS_Q, (size_t)M_PAD * 512}, {WS_K, (size_t)NB * LTOT * 512}, {WS_V, (size_t)NB * LTOT * 512}, {WS_U, (size_t)NB * LTOT * 512}
#endif
#ifndef DUMP_F32
#define DUMP_F32 {WS_SSA, (size_t)M_PAD * 16}
#endif
#ifndef DUMP_FSCALE
#define DUMP_FSCALE 0.f
#endif
struct DumpEnt { size_t off, cnt; };
__global__ void dump_kernel(const unsigned char* ws, float* out) {
    const DumpEnt L[] = {DUMP_LIST}; const DumpEnt F[] = {DUMP_F32};
    for (size_t i = (size_t)blockIdx.x * blockDim.x + threadIdx.x; i < (size_t)M_MAIN * D; i += (size_t)gridDim.x * blockDim.x) {
        float v = 0.f;
        for (unsigned j = 0; j < sizeof(L) / sizeof(L[0]); ++j) { const unsigned short h = ((const unsigned short*)(ws + L[j].off))[i % L[j].cnt]; v += __uint_as_float((unsigned)h << 16); }
        for (unsigned j = 0; j < sizeof(F) / sizeof(F[0]); ++j) v += DUMP_FSCALE * ((const float*)(ws + F[j].off))[i % F[j].cnt];
        out[i] = v;
    }
}
#endif
#ifndef MK_LAUNCH_PER_PHASE
#define MK_LAUNCH_PER_PHASE 1
#endif
extern "C" void kernel_launch(void* const* d_in, const int* in_sizes, int n_in, void* d_out, int out_size, void* d_ws, size_t ws_size, hipStream_t stream) {
    static int grid = 0;
    if (grid == 0) {
        if (n_in != 14 || in_sizes[0] != M_MAIN * D || out_size != M_MAIN * D || ws_size < WS_WUT + 4 * MiB) { fprintf(stderr, "kernel_launch: unexpected shapes: n_in %d in0 %d out %d ws %zu (need %zu)\n", n_in, n_in > 0 ? in_sizes[0] : -1, out_size, ws_size, (size_t)WS_END); grid = -1; return; }
        int dev = 0, cus = 0, per_cu = 0;
        if (hipGetDevice(&dev) != hipSuccess || hipDeviceGetAttribute(&cus, hipDeviceAttributeMultiprocessorCount, dev) != hipSuccess) { fprintf(stderr, "kernel_launch: device query failed\n"); grid = -1; return; }
        if (hipFuncSetAttribute((const void*)fwd_kernel, hipFuncAttributeMaxDynamicSharedMemorySize, LDS_BYTES) != hipSuccess) { fprintf(stderr, "kernel_launch: hipFuncSetAttribute failed\n"); grid = -1; return; }
        if (hipOccupancyMaxActiveBlocksPerMultiprocessor(&per_cu, (const void*)fwd_kernel, NWAVES * 64, LDS_BYTES) != hipSuccess || per_cu < 1)
            fprintf(stderr, "kernel_launch: note: occupancy query reports %d workgroups per CU\n", per_cu);
        (void)hipGetLastError();
        grid = cus;
    }
    if (grid < 0) return;
    if (hipMemsetAsync((char*)d_ws + WS_CTL, 0, CTL_ZERO_BYTES, stream) != hipSuccess) { fprintf(stderr, "kernel_launch: memset failed\n"); return; }
    Args a{};
    for (int i = 0; i < 14; ++i) a.in[i] = (const float*)d_in[i];
    a.out = (float*)d_out; a.ws = (unsigned char*)d_ws;
#if defined(DUMP_AFTER)
    for (int p = 0; p <= DUMP_AFTER; ++p) { a.ph_lo = p; a.ph_hi = p + 1; hipLaunchKernelGGL(fwd_kernel, dim3(grid), dim3(NWAVES * 64), LDS_BYTES, stream, a); }
    hipLaunchKernelGGL(dump_kernel, dim3(2048), dim3(256), 0, stream, (const unsigned char*)d_ws, (float*)d_out);
#elif MK_LAUNCH_PER_PHASE
    for (int p = 0; p < N_PHASES; ++p) { a.ph_lo = p; a.ph_hi = p + 1; hipLaunchKernelGGL(fwd_kernel, dim3(grid), dim3(NWAVES * 64), LDS_BYTES, stream, a); }
#else
    a.ph_lo = 0; a.ph_hi = N_PHASES; hipLaunchKernelGGL(fwd_kernel, dim3(grid), dim3(NWAVES * 64), LDS_BYTES, stream, a);
#endif
    const hipError_t le = hipPeekAtLastError();
    if (le != hipSuccess) fprintf(stderr, "kernel_launch: launch failed: %s\n", hipGetErrorName(le));
}
```
